# Optimizing an MI355X kernel written in HIP

```python
import math
import jax, jax.numpy as jnp
from jax import lax
import numpy as np

D_MODEL = 1024
BATCH = 8
SEQ = 2048
DEPTH = 4
DEC_BATCH = 128
DEC_SEQ = 1
PAST_LEN = 16384
PAGE_SIZE = 128

N_META = 16
D_CONV = D_MODEL
CONV_A_WIDTH = 3
CONV_A_GROUPS = 16
D_RNN = D_MODEL
RG_HEADS = 16
RG_HEAD_DIM = D_RNN // RG_HEADS
CONV_B_WIDTH = 4
RG_C = 8.0
D_FF = 2816
FFN_CONV_WIDTH = 3
EPS = 1e-6
D_IN = 3 * D_CONV + 2 * D_RNN + 2 * D_MODEL

kernel_name = "hybrid_shortconv_rglru_convffn_meta_step"


def _rmsnorm(x, g):
    xf = x.astype(jnp.float32)
    y = xf * lax.rsqrt(jnp.mean(xf * xf, axis=-1, keepdims=True) + EPS)
    return (y * g.astype(jnp.float32)).astype(x.dtype)


def _causal_dwconv(x, buf, w):
    width = w.shape[0]
    t = x.shape[1]
    xp = jnp.concatenate([buf.astype(x.dtype), x], axis=1)
    y = xp[:, 0:t] * w[0]
    for k in range(1, width):
        y = y + xp[:, k:k + t] * w[k]
    return y, xp[:, xp.shape[1] - (width - 1):]


def _rg_lru(xc, h0, w_a, b_a, w_x, b_x, lam, is_first):
    bn, t, c = xc.shape
    xh = xc.reshape(bn, t, RG_HEADS, RG_HEAD_DIM)
    r = jax.nn.sigmoid(jnp.einsum('bthi,hij->bthj', xh, w_a).reshape(bn, t, c) + b_a)
    i = jax.nn.sigmoid(jnp.einsum('bthi,hij->bthj', xh, w_x).reshape(bn, t, c) + b_x)
    log_a = -RG_C * r.astype(jnp.float32) * jax.nn.softplus(-lam.astype(jnp.float32))
    a = jnp.exp(log_a)
    mult = jnp.sqrt(-jnp.expm1(2.0 * log_a))
    mult = jnp.where(is_first[None, :, None], 1.0, mult)
    b = mult * (i * xc).astype(jnp.float32)

    def step(h, ab):
        h = ab[0] * h + ab[1]
        return h, h

    h_last, hs = lax.scan(step, h0.astype(jnp.float32),
                          (a.transpose(1, 0, 2), b.transpose(1, 0, 2)))
    return hs.transpose(1, 0, 2).astype(xc.dtype), h_last


def _layer(x, buf_a, buf_b, h0, buf_f, is_first, norm_mix, norm_ffn, w_in, b_gate,
           conv_a_w, w_a_out, conv_b_w, conv_b_b, rg_w_a, rg_b_a, rg_w_x, rg_b_x,
           rg_lambda, w_b_out, w_o, ffn_w_up, ffn_w_gate, ffn_conv_w, ffn_conv_b, ffn_w_down):
    hn = _rmsnorm(x, norm_mix)
    proj = hn @ w_in
    o = 0
    gB = proj[..., o:o + D_CONV]; o += D_CONV
    gC = proj[..., o:o + D_CONV]; o += D_CONV
    ha = proj[..., o:o + D_CONV]; o += D_CONV
    xr = proj[..., o:o + D_RNN]; o += D_RNN
    gr = proj[..., o:o + D_RNN]; o += D_RNN
    merge = proj[..., o:o + 2 * D_MODEL] + b_gate
    conv_a, nbuf_a = _causal_dwconv(gC * ha, buf_a, conv_a_w)
    y_a = (gB * conv_a) @ w_a_out
    xc, nbuf_b = _causal_dwconv(xr, buf_b, conv_b_w)
    xc = xc + conv_b_b
    hs, h_last = _rg_lru(xc, h0, rg_w_a, rg_b_a, rg_w_x, rg_b_x, rg_lambda, is_first)
    y_b = (jax.nn.gelu(gr, approximate=True) * hs) @ w_b_out
    mixed = (jax.nn.sigmoid(merge[..., :D_MODEL]) * y_a
             + jax.nn.sigmoid(merge[..., D_MODEL:]) * y_b)
    x = x + mixed @ w_o
    hf = _rmsnorm(x, norm_ffn)
    u = hf @ ffn_w_up
    uc, nbuf_f = _causal_dwconv(u, buf_f, ffn_conv_w)
    uc = uc + ffn_conv_b
    x = x + (jax.nn.silu(uc) * (hf @ ffn_w_gate)) @ ffn_w_down
    return x, nbuf_a, nbuf_b, h_last.astype(x.dtype), nbuf_f


def _trunk(x, start_pos, bufs_a, bufs_b, hs0, bufs_f, norm_mix, norm_ffn, norm_final, w_in,
           b_gate, conv_a_w, w_a_out, conv_b_w, conv_b_b, rg_w_a, rg_b_a, rg_w_x, rg_b_x,
           rg_lambda, w_b_out, w_o, ffn_w_up, ffn_w_gate, ffn_conv_w, ffn_conv_b, ffn_w_down):
    t = x.shape[1]
    is_first = (start_pos + jnp.arange(t)) == 0
    na, nb, nh, nf = [], [], [], []
    for l in range(DEPTH):
        x, a_, b_, h_, f_ = _layer(
            x, bufs_a[l], bufs_b[l], hs0[l], bufs_f[l], is_first, norm_mix[l], norm_ffn[l],
            w_in[l], b_gate[l], conv_a_w[l], w_a_out[l], conv_b_w[l], conv_b_b[l], rg_w_a[l],
            rg_b_a[l], rg_w_x[l], rg_b_x[l], rg_lambda[l], w_b_out[l], w_o[l], ffn_w_up[l],
            ffn_w_gate[l], ffn_conv_w[l], ffn_conv_b[l], ffn_w_down[l])
        na.append(a_); nb.append(b_); nh.append(h_); nf.append(f_)
    y = _rmsnorm(x, norm_final)
    return y, jnp.stack(na), jnp.stack(nb), jnp.stack(nh), jnp.stack(nf)


def setup_inputs(seed: int = 0) -> dict:
    key = jax.random.key(seed)
    ks = jax.random.split(key, 40)
    f32 = jnp.float32
    nrm = lambda k, shape, s: jax.random.normal(k, shape, f32) * s
    u = jax.random.uniform(ks[30], (DEPTH, D_RNN), f32, 0.9, 0.999)
    s = u ** (1.0 / RG_C)
    rg_lambda = jnp.log(s) - jnp.log1p(-s)
    return {
        "x_prompt": nrm(ks[0], (BATCH, SEQ, D_MODEL), 1.0),
        "x_sample": nrm(ks[1], (DEC_BATCH, DEC_SEQ, D_MODEL), 1.0),
        "state_conv_a": nrm(ks[2], (DEPTH, DEC_BATCH, CONV_A_WIDTH - 1, D_CONV), 1.0),
        "state_conv_b": nrm(ks[3], (DEPTH, DEC_BATCH, CONV_B_WIDTH - 1, D_RNN), 1.0),
        "state_rglru": nrm(ks[4], (DEPTH, DEC_BATCH, D_RNN), 0.5),
        "state_conv_ffn": nrm(ks[5], (DEPTH, DEC_BATCH, FFN_CONV_WIDTH - 1, D_FF), 1.0),
        "meta_tokens": nrm(ks[6], (N_META, D_MODEL), 1.0),
        "norm_mix": 1.0 + nrm(ks[7], (DEPTH, D_MODEL), 0.02),
        "norm_ffn": 1.0 + nrm(ks[8], (DEPTH, D_MODEL), 0.02),
        "norm_final": 1.0 + nrm(ks[9], (D_MODEL,), 0.02),
        "w_in": nrm(ks[10], (DEPTH, D_MODEL, D_IN), D_MODEL ** -0.5),
        "b_gate": nrm(ks[11], (DEPTH, 2 * D_MODEL), 0.02),
        "conv_a_w": nrm(ks[12], (DEPTH, CONV_A_WIDTH, D_CONV), CONV_A_WIDTH ** -0.5),
        "w_a_out": nrm(ks[13], (DEPTH, D_CONV, D_MODEL), D_CONV ** -0.5),
        "conv_b_w": nrm(ks[14], (DEPTH, CONV_B_WIDTH, D_RNN), CONV_B_WIDTH ** -0.5),
        "conv_b_b": nrm(ks[15], (DEPTH, D_RNN), 0.02),
        "rg_w_a": nrm(ks[16], (DEPTH, RG_HEADS, RG_HEAD_DIM, RG_HEAD_DIM), RG_HEAD_DIM ** -0.5),
        "rg_b_a": nrm(ks[17], (DEPTH, D_RNN), 0.02),
        "rg_w_x": nrm(ks[18], (DEPTH, RG_HEADS, RG_HEAD_DIM, RG_HEAD_DIM), RG_HEAD_DIM ** -0.5),
        "rg_b_x": nrm(ks[19], (DEPTH, D_RNN), 0.02),
        "rg_lambda": rg_lambda,
        "w_b_out": nrm(ks[20], (DEPTH, D_RNN, D_MODEL), D_RNN ** -0.5),
        "w_o": nrm(ks[21], (DEPTH, D_MODEL, D_MODEL), D_MODEL ** -0.5),
        "ffn_w_up": nrm(ks[22], (DEPTH, D_MODEL, D_FF), D_MODEL ** -0.5),
        "ffn_w_gate": nrm(ks[23], (DEPTH, D_MODEL, D_FF), D_MODEL ** -0.5),
        "ffn_conv_w": nrm(ks[24], (DEPTH, FFN_CONV_WIDTH, D_FF), FFN_CONV_WIDTH ** -0.5),
        "ffn_conv_b": nrm(ks[25], (DEPTH, D_FF), 0.02),
        "ffn_w_down": nrm(ks[26], (DEPTH, D_FF, D_MODEL), D_FF ** -0.5),
    }


def reference(x_prompt, x_sample, state_conv_a, state_conv_b, state_rglru, state_conv_ffn,
              meta_tokens, norm_mix, norm_ffn, norm_final, w_in, b_gate, conv_a_w, w_a_out,
              conv_b_w, conv_b_b, rg_w_a, rg_b_a, rg_w_x, rg_b_x, rg_lambda, w_b_out, w_o,
              ffn_w_up, ffn_w_gate, ffn_conv_w, ffn_conv_b, ffn_w_down):
    weights = (norm_mix, norm_ffn, norm_final, w_in, b_gate, conv_a_w, w_a_out, conv_b_w,
               conv_b_b, rg_w_a, rg_b_a, rg_w_x, rg_b_x, rg_lambda, w_b_out, w_o, ffn_w_up,
               ffn_w_gate, ffn_conv_w, ffn_conv_b, ffn_w_down)
    bp = x_prompt.shape[0]
    dt = x_prompt.dtype
    xp = jnp.concatenate(
        [jnp.broadcast_to(meta_tokens.astype(dt)[None], (bp, N_META, D_MODEL)), x_prompt], axis=1)
    z_a = jnp.zeros((DEPTH, bp, CONV_A_WIDTH - 1, D_CONV), dt)
    z_b = jnp.zeros((DEPTH, bp, CONV_B_WIDTH - 1, D_RNN), dt)
    z_h = jnp.zeros((DEPTH, bp, D_RNN), dt)
    z_f = jnp.zeros((DEPTH, bp, FFN_CONV_WIDTH - 1, D_FF), dt)
    yp, p_conv_a, p_conv_b, p_rglru, p_conv_ffn = _trunk(xp, 0, z_a, z_b, z_h, z_f, *weights)
    y_prompt = yp[:, N_META:]
    y_sample, s_conv_a, s_conv_b, s_rglru, s_conv_ffn = _trunk(
        x_sample, PAST_LEN, state_conv_a, state_conv_b, state_rglru, state_conv_ffn, *weights)
    return (y_prompt, y_sample, p_conv_a, p_conv_b, p_rglru, p_conv_ffn,
            s_conv_a, s_conv_b, s_rglru, s_conv_ffn)
```

```cpp
#include <hip/hip_runtime.h>
#include <hip/hip_cooperative_groups.h>
#include <cstdio>
namespace cg = cooperative_groups;

#define LAS __attribute__((address_space(3)))
typedef unsigned short bf16_t;
typedef short bf16x8 __attribute__((ext_vector_type(8)));
typedef float f32x4 __attribute__((ext_vector_type(4)));
typedef float f32x2 __attribute__((ext_vector_type(2)));
typedef unsigned u32x4 __attribute__((ext_vector_type(4)));
typedef unsigned u32x2 __attribute__((ext_vector_type(2)));

constexpr int D = 1024, DIN = 7168, DFF = 2816, DUG = 5632, NB = 8, TP = 2064, MP = NB * TP, MS = 128, M = MP + MS, DEPTH = 4, NMETA = 16, SEQ = 2048;
constexpr float EPS = 1e-6f;
constexpr int DP = 5120, C_UA = 0, C_MA = 1024, C_XR = 2048, C_GR = 3072, C_MB = 4096, C_MIX = 2048;
constexpr size_t O_YP = 0, O_YS = O_YP + (size_t)NB * SEQ * D, O_PCA = O_YS + (size_t)MS * D, O_PCB = O_PCA + (size_t)DEPTH * NB * 2 * D,
                 O_PRG = O_PCB + (size_t)DEPTH * NB * 3 * D, O_PCF = O_PRG + (size_t)DEPTH * NB * D, O_SCA = O_PCF + (size_t)DEPTH * NB * 2 * DFF,
                 O_SCB = O_SCA + (size_t)DEPTH * MS * 2 * D, O_SRG = O_SCB + (size_t)DEPTH * MS * 3 * D, O_SCF = O_SRG + (size_t)DEPTH * MS * D,
                 O_END = O_SCF + (size_t)DEPTH * MS * 2 * DFF;
constexpr size_t al256(size_t x) { return (x + 255) & ~(size_t)255; }
constexpr size_t WS_WIN = 0, WS_WA = WS_WIN + (size_t)DIN * D * 2, WS_WB = WS_WA + (size_t)D * D * 2, WS_WO = WS_WB + (size_t)D * D * 2,
                 WS_WUG = WS_WO + (size_t)D * D * 2, WS_WD = WS_WUG + (size_t)DUG * D * 2, WS_RGA = WS_WD + (size_t)D * DFF * 2, WS_RGX = WS_RGA + 16 * 64 * 64 * 2,
                 WS_BIASP = WS_RGX + 16 * 64 * 64 * 2, WS_SP = WS_BIASP + (size_t)DIN * 4, WS_SUMM = WS_SP + (size_t)D * 4,
                 WS_X = al256(WS_SUMM + (size_t)128 * 2 * D * 4), WS_BIG = WS_X + (size_t)M * D * 4, WS_R2 = WS_BIG + (size_t)M * DIN * 2,
                 WS_BAR = WS_R2 + (size_t)M * DFF * 2, WS_SLAB = WS_BAR + 16384, WS_END = WS_SLAB + (size_t)11 * 256 * D * 4;
constexpr size_t R2_PCUM = (size_t)M * D * 2;

struct Params {
    const float* in[28];
    float* out;
    unsigned char* ws;
};

typedef const Params __attribute__((address_space(4)))* KP;
__device__ __forceinline__ KP kargs() { KP k = (KP)__builtin_amdgcn_kernarg_segment_ptr(); asm volatile("" : "+s"(k)); return k; }

__device__ __forceinline__ int tid_() { int t = threadIdx.x; asm volatile("" : "+v"(t)); return t; }
__device__ __forceinline__ int bid_() { int t = blockIdx.x; asm volatile("" : "+s"(t)); return t; }
__device__ __forceinline__ int gdim_() { int t = gridDim.x; asm volatile("" : "+s"(t)); return t; }

__device__ __forceinline__ unsigned cvt_pk_bf16(float lo, float hi) { unsigned r; asm("v_cvt_pk_bf16_f32 %0, %1, %2" : "=v"(r) : "v"(lo), "v"(hi)); return r; }
__device__ __forceinline__ float bflo(unsigned w) { return __uint_as_float(w << 16); }
__device__ __forceinline__ float bfhi(unsigned w) { return __uint_as_float(w & 0xffff0000u); }
__device__ __forceinline__ void unpack8(const u32x4 v, float (&f)[8]) {
    f[0] = bflo(v.x); f[1] = bfhi(v.x); f[2] = bflo(v.y); f[3] = bfhi(v.y); f[4] = bflo(v.z); f[5] = bfhi(v.z); f[6] = bflo(v.w); f[7] = bfhi(v.w);
}
__device__ __forceinline__ u32x4 pack8(const float (&f)[8]) { u32x4 o; o.x = cvt_pk_bf16(f[0], f[1]); o.y = cvt_pk_bf16(f[2], f[3]); o.z = cvt_pk_bf16(f[4], f[5]); o.w = cvt_pk_bf16(f[6], f[7]); return o; }
__device__ __forceinline__ float sigmoidf_(float x) { return __builtin_amdgcn_rcpf(1.0f + __expf(-x)); }
__device__ __forceinline__ float gelu_tanh(float x) { return x * sigmoidf_(1.5957691216057308f * (x + 0.044715f * x * x * x)); }
__device__ __forceinline__ float wave_sum(float v) {
#pragma unroll
    for (int o = 1; o < 64; o <<= 1) v += __shfl_xor(v, o);
    return v;
}
__device__ __forceinline__ void load8f(const float* p, float (&f)[8]) { const f32x4 a = *(const f32x4*)p, b = *(const f32x4*)(p + 4); f[0] = a[0]; f[1] = a[1]; f[2] = a[2]; f[3] = a[3]; f[4] = b[0]; f[5] = b[1]; f[6] = b[2]; f[7] = b[3]; }
__device__ __forceinline__ void store8f(float* p, const float (&f)[8]) { *(f32x4*)p = (f32x4){f[0], f[1], f[2], f[3]}; *(f32x4*)(p + 4) = (f32x4){f[4], f[5], f[6], f[7]}; }
#define LDS_WAIT() asm volatile("s_waitcnt lgkmcnt(0)" ::: "memory")

namespace pg8 {
constexpr int BM = 256, BK = 64, HALF = 128, HTB = HALF * BK * 2, STAGE_BYTES = 8 * HTB, NXCD = 8, WGM = 8;
__device__ __forceinline__ int lds_byte(int r, int c) { const int st = (r >> 4) * 2 + (c >> 5), rr = r & 15, cc = c & 31, ob = rr * 64 + cc * 2; return st * 1024 + (ob ^ (((ob >> 9) & 1) << 5)); }
__device__ __forceinline__ void stage_rc(int b, int& R, int& C) { const int st = b / 1024, sb = b % 1024, swz = sb ^ (((sb >> 9) & 1) << 5); R = (st >> 1) * 16 + swz / 64; C = (st & 1) * 32 + (swz % 64) / 2; }
__device__ __forceinline__ int perm32(int rho) { const int n = rho >> 4, i = rho & 15; return 8 * (i >> 2) + 4 * n + (i & 3); }

struct Unit { int pm, pn, z, kt0, nkt; };
struct Gemm { const bf16_t* A0; const bf16_t* A1; const bf16_t* B0; const bf16_t* B1; int lda, K; };
struct Order {
    int nM, nN, nwg, G, c, nZ, splitS, ntFull, nmain;
    __device__ void init(int M_, int N_, int K_, int G_, int c_, int nZ_, int splitS_) { nM = M_ / BM; nN = N_ / BM; splitS = splitS_; if (splitS) nM -= 1; nwg = nM * nN; G = G_; c = c_; nZ = nZ_; ntFull = K_ / BK;
        nmain = c < nwg ? (nwg - c + G - 1) / G : 0; }
    __device__ bool next(int i, Unit& u) const {
        if (i < nZ * nmain) {
            const int ti = (nZ == 2) ? (i >> 1) : i;
            int wgid = ti * G + c; { const int q = nwg / NXCD, r = nwg % NXCD, xcd = wgid % NXCD, off = wgid / NXCD; wgid = (xcd < r ? xcd * (q + 1) : r * (q + 1) + (xcd - r) * q) + off; }
            const int nig = WGM * nN, gid = wgid / nig, fm = gid * WGM, gsz = (nM - fm) < WGM ? (nM - fm) : WGM;
            u.pm = fm + ((wgid % nig) % gsz); u.pn = (wgid % nig) / gsz; u.z = (nZ == 2) ? (i & 1) : 0; u.kt0 = 0; u.nkt = ntFull; return true;
        }
        if (!splitS) return false;
        const int e = (i - nZ * nmain) * G + c; if (e >= nN * nZ * splitS) return false;
        u.pm = nM; u.pn = e % nN; const int zs = e / nN; u.z = (nZ == 2) ? (zs & 1) : 0; u.kt0 = ((nZ == 2) ? (zs >> 1) : zs) * 4; u.nkt = 4; return true;
    }
};

struct EpiBf16 {
    static constexpr bool PERM = true, CHAIN = false;
    bf16_t* O; int ldc; const float* bias;
    __device__ __forceinline__ void operator()(const f32x4 (&acc)[2][2][4][2], const Unit& u, int wr, int wc, int fr, int fq) const {
        const int row0 = u.pm * BM + wr * 64 + fr, col0 = u.pn * BM + wc * 32 + 8 * fq;
        f32x4 bv[2][2];
#pragma unroll
        for (int bj = 0; bj < 2; ++bj)
#pragma unroll
            for (int n = 0; n < 2; ++n) bv[bj][n] = bias ? *(const f32x4*)(bias + col0 + bj * HALF + 4 * n) : (f32x4){0.f, 0.f, 0.f, 0.f};
#pragma unroll
        for (int ai = 0; ai < 2; ++ai)
#pragma unroll
            for (int m = 0; m < 4; ++m) { bf16_t* rowp = O + (size_t)(row0 + ai * HALF + m * 16) * ldc + col0;
#pragma unroll
                for (int bj = 0; bj < 2; ++bj) { const f32x4 v0 = acc[ai][bj][m][0] + bv[bj][0], v1 = acc[ai][bj][m][1] + bv[bj][1];
                    u32x4 w; w.x = cvt_pk_bf16(v0[0], v0[1]); w.y = cvt_pk_bf16(v0[2], v0[3]); w.z = cvt_pk_bf16(v1[0], v1[1]); w.w = cvt_pk_bf16(v1[2], v1[3]);
                    *(u32x4*)(rowp + bj * HALF) = w; } }
    }
};
struct EpiRes {
    static constexpr bool PERM = true, CHAIN = false;
    bf16_t* X; float* SLAB; int ntFull;
    __device__ __forceinline__ void operator()(const f32x4 (&acc)[2][2][4][2], const Unit& u, int wr, int wc, int fr, int fq) const {
        const int row0 = u.pm * BM + wr * 64 + fr, col0 = u.pn * BM + wc * 32 + 8 * fq;
        if (u.nkt == ntFull) {
#pragma unroll
            for (int ai = 0; ai < 2; ++ai)
#pragma unroll
                for (int m = 0; m < 4; ++m) { bf16_t* rowp = X + (size_t)(row0 + ai * HALF + m * 16) * D + col0;
#pragma unroll
                    for (int bj = 0; bj < 2; ++bj) { u32x4* p = (u32x4*)(rowp + bj * HALF); float x[8]; unpack8(*p, x); const f32x4 a0 = acc[ai][bj][m][0], a1 = acc[ai][bj][m][1];
#pragma unroll
                        for (int e = 0; e < 4; ++e) { x[e] += a0[e]; x[4 + e] += a1[e]; }
                        *p = pack8(x); }
                    asm volatile("" ::: "memory"); }
        } else {
            float* S0 = SLAB + (size_t)(u.kt0 >> 2) * 256 * D;
#pragma unroll
            for (int ai = 0; ai < 2; ++ai)
#pragma unroll
                for (int m = 0; m < 4; ++m) { float* rowp = S0 + (size_t)(wr * 64 + fr + ai * HALF + m * 16) * D + col0;
#pragma unroll
                    for (int bj = 0; bj < 2; ++bj) { *(f32x4*)(rowp + bj * HALF) = acc[ai][bj][m][0]; *(f32x4*)(rowp + bj * HALF + 4) = acc[ai][bj][m][1]; } }
        }
    }
};
struct EpiAB {
    static constexpr bool PERM = true, CHAIN = true;
    bf16_t* P; float* SLAB; int ntFull;
    __device__ __forceinline__ void mid(f32x4 (&acc)[2][2][4][2], const Unit& u, int wr, int wc, int fr, int fq) const {
        const int row0 = u.pm * BM + wr * 64 + fr, col0 = u.pn * BM + wc * 32 + 8 * fq;
#pragma unroll
        for (int ai = 0; ai < 2; ++ai)
#pragma unroll
            for (int m = 0; m < 4; ++m) { const bf16_t* prow = P + (size_t)(row0 + ai * HALF + m * 16) * DP;
#pragma unroll
                for (int bj = 0; bj < 2; ++bj) { const int c = col0 + bj * HALF;
                    float ga[8], gb[8]; unpack8(__builtin_nontemporal_load((const u32x4*)(prow + C_MA + c)), ga); unpack8(*(const u32x4*)(prow + C_MB + c), gb);
#pragma unroll
                    for (int e = 0; e < 4; ++e) { acc[ai][bj][m][0][e] *= (1.0f + __expf(-gb[e])) * __builtin_amdgcn_rcpf(1.0f + __expf(-ga[e]));
                                                  acc[ai][bj][m][1][e] *= (1.0f + __expf(-gb[4 + e])) * __builtin_amdgcn_rcpf(1.0f + __expf(-ga[4 + e])); } }
                asm volatile("" ::: "memory"); }
    }
    __device__ __forceinline__ void operator()(const f32x4 (&acc)[2][2][4][2], const Unit& u, int wr, int wc, int fr, int fq) const {
        const int row0 = u.pm * BM + wr * 64 + fr, col0 = u.pn * BM + wc * 32 + 8 * fq;
        const bool split = u.nkt != ntFull;
        const int goff = (split && u.z == 0) ? C_MA : C_MB;
        float* S0 = SLAB + (size_t)((u.kt0 >> 2) * 2 + u.z) * 256 * D;
#pragma unroll
        for (int ai = 0; ai < 2; ++ai)
#pragma unroll
            for (int m = 0; m < 4; ++m) { const size_t r = (size_t)(row0 + ai * HALF + m * 16); bf16_t* prow = P + r * DP;
                float* srow = S0 + (size_t)(wr * 64 + fr + ai * HALF + m * 16) * D;
#pragma unroll
                for (int bj = 0; bj < 2; ++bj) { const int c = col0 + bj * HALF;
                    const u32x4 gw = *(const u32x4*)(prow + goff + c); float g[8]; unpack8(gw, g);
                    const f32x4 v0 = acc[ai][bj][m][0], v1 = acc[ai][bj][m][1];
                    float o[8];
#pragma unroll
                    for (int e = 0; e < 4; ++e) { o[e] = sigmoidf_(g[e]) * v0[e]; o[4 + e] = sigmoidf_(g[4 + e]) * v1[e]; }
                    if (split) store8f(srow + c, o); else *(u32x4*)(prow + C_MIX + c) = pack8(o); }
                asm volatile("" ::: "memory"); }
    }
};

__device__ __forceinline__ float dpp_ror1(float x) { return __builtin_bit_cast(float, __builtin_amdgcn_update_dpp(0, __builtin_bit_cast(int, x), 0x121, 0xf, 0xf, false)); }
__device__ __forceinline__ float dpp_ror2(float x) { return __builtin_bit_cast(float, __builtin_amdgcn_update_dpp(0, __builtin_bit_cast(int, x), 0x122, 0xf, 0xf, false)); }
struct EpiFfn {
    static constexpr bool PERM = true, CHAIN = false;
    bf16_t* ACT; bf16_t* EF; bf16_t* EL; const float* cw; const float* cb; const float* st; float* outp; float* outs;
    __device__ __forceinline__ void operator()(const f32x4 (&acc)[2][2][4][2], const Unit& u, int wr, int wc, int fr, int fq) const {
        const int ch0 = u.pn * 128 + wc * 32 + 8 * fq;
        float w0[8], w1[8], w2[8], bb[8]; load8f(cw + ch0, w0); load8f(cw + DFF + ch0, w1); load8f(cw + 2 * DFF + ch0, w2); load8f(cb + ch0, bb);
        const int rbase = u.pm * BM + wr * 64 + fr;
        const int b0 = (u.pm * BM) / TP, rb = (b0 + 1) * TP;
#pragma unroll
        for (int ai = 0; ai < 2; ++ai) {
            if (u.pm == 64 && ai == 1) {
#pragma unroll
                for (int m = 0; m < 4; ++m) { const int r = rbase + HALF + 16 * m, sb = r - MP;
                    float u2[8], u1[8], o[8], uu[8]; load8f(st + (size_t)(sb * 2) * DFF + ch0, u2); load8f(st + (size_t)(sb * 2 + 1) * DFF + ch0, u1);
#pragma unroll
                    for (int k = 0; k < 8; ++k) { const float x = acc[1][0][m][k >> 2][k & 3], g = acc[1][1][m][k >> 2][k & 3]; uu[k] = x;
                        const float uc = w0[k] * u2[k] + w1[k] * u1[k] + w2[k] * x + bb[k]; o[k] = uc * sigmoidf_(uc) * g; }
                    *(u32x4*)(ACT + (size_t)r * DFF + ch0) = pack8(o);
                    store8f(outs + (size_t)(sb * 2) * DFF + ch0, u1); store8f(outs + (size_t)(sb * 2 + 1) * DFF + ch0, uu); }
            } else {
#pragma unroll
                for (int m = 0; m < 4; ++m) { const int r = rbase + ai * HALF + 16 * m; const bool hi = r >= rb; const int t = hi ? r - rb : r - b0 * TP, b = hi ? b0 + 1 : b0;
                    float o[8], uu[8], gg[8];
#pragma unroll
                    for (int k = 0; k < 8; ++k) { const float x = acc[ai][0][m][k >> 2][k & 3], g = acc[ai][1][m][k >> 2][k & 3]; uu[k] = x; gg[k] = g;
                        float u1 = dpp_ror1(x), u2 = dpp_ror2(x);
                        if (m > 0) { const float xp = acc[ai][0][m > 0 ? m - 1 : 0][k >> 2][k & 3]; const float p1 = dpp_ror1(xp), p2 = dpp_ror2(xp); u1 = fr >= 1 ? u1 : p1; u2 = fr >= 2 ? u2 : p2; }
                        if (t == 0) u1 = 0.f; if (t <= 1) u2 = 0.f;
                        const float uc = w0[k] * u2 + w1[k] * u1 + w2[k] * x + bb[k]; o[k] = uc * sigmoidf_(uc) * g; }
                    if (m > 0 || fr >= 2) *(u32x4*)(ACT + (size_t)r * DFF + ch0) = pack8(o);
                    if (m == 0 && fr < 2) { const int blk = r >> 6; *(u32x4*)(EF + ((size_t)(blk * 2 + fr) * 2) * DFF + ch0) = pack8(uu); *(u32x4*)(EF + ((size_t)(blk * 2 + fr) * 2 + 1) * DFF + ch0) = pack8(gg); }
                    if (m == 3 && fr >= 14) { const int blk = r >> 6; *(u32x4*)(EL + (size_t)(blk * 2 + (fr - 14)) * DFF + ch0) = pack8(uu); }
                    if (t >= TP - 2) store8f(outp + ((size_t)(b * 2) + (t - (TP - 2))) * DFF + ch0, uu); }
            }
        }
    }
};

struct EpiProj {
    static constexpr bool PERM = true, CHAIN = false;
    bf16_t* O; const float* bias; bf16_t* EFA; bf16_t* ELA; const float* cw; const float* st; float* outp; float* outs;
    __device__ __forceinline__ void operator()(const f32x4 (&acc)[2][2][4][2], const Unit& u, int wr, int wc, int fr, int fq) const {
        const int rbase = u.pm * BM + wr * 64 + fr;
        if (u.pn >= 16) {
            const int col0 = u.pn * BM + wc * 32 + 8 * fq;
            f32x4 bv[2][2];
#pragma unroll
            for (int bj = 0; bj < 2; ++bj)
#pragma unroll
                for (int n = 0; n < 2; ++n) bv[bj][n] = *(const f32x4*)(bias + col0 + bj * HALF + 4 * n);
#pragma unroll
            for (int ai = 0; ai < 2; ++ai)
#pragma unroll
                for (int m = 0; m < 4; ++m) { bf16_t* rowp = O + (size_t)(rbase + ai * HALF + m * 16) * DP + (col0 - 2048);
#pragma unroll
                    for (int bj = 0; bj < 2; ++bj) { const f32x4 v0 = acc[ai][bj][m][0] + bv[bj][0], v1 = acc[ai][bj][m][1] + bv[bj][1];
                        u32x4 w; w.x = cvt_pk_bf16(v0[0], v0[1]); w.y = cvt_pk_bf16(v0[2], v0[3]); w.z = cvt_pk_bf16(v1[0], v1[1]); w.w = cvt_pk_bf16(v1[2], v1[3]);
                        *(u32x4*)(rowp + bj * HALF) = w; } }
            return;
        }
        const int xch = u.pn * 64 + wc * 16 + 4 * fq;
        const f32x4 w0 = *(const f32x4*)(cw + xch), w1 = *(const f32x4*)(cw + D + xch), w2 = *(const f32x4*)(cw + 2 * D + xch);
        const f32x4 bm = *(const f32x4*)(bias + u.pn * BM + HALF + wc * 32 + 8 * fq + 4);
        const int b0 = (u.pm * BM) / TP, rb = (b0 + 1) * TP;
#pragma unroll
        for (int ai = 0; ai < 2; ++ai) {
            f32x4 z[4];
#pragma unroll
            for (int m = 0; m < 4; ++m) z[m] = acc[ai][0][m][1] * acc[ai][1][m][0];
            if (u.pm == 64 && ai == 1) {
#pragma unroll
                for (int m = 0; m < 4; ++m) { const int r = rbase + HALF + 16 * m, sb = r - MP;
                    const f32x4 z2 = *(const f32x4*)(st + (size_t)(sb * 2) * D + xch), z1 = *(const f32x4*)(st + (size_t)(sb * 2 + 1) * D + xch);
                    const f32x4 ua = acc[1][0][m][0] * (w0 * z2 + w1 * z1 + w2 * z[m]), ma = acc[1][1][m][1] + bm;
                    bf16_t* rowp = O + (size_t)r * DP + xch;
                    u32x2 a; a.x = cvt_pk_bf16(ua[0], ua[1]); a.y = cvt_pk_bf16(ua[2], ua[3]); *(u32x2*)(rowp + C_UA) = a;
                    u32x2 g; g.x = cvt_pk_bf16(ma[0], ma[1]); g.y = cvt_pk_bf16(ma[2], ma[3]); *(u32x2*)(rowp + C_MA) = g;
                    *(f32x4*)(outs + (size_t)(sb * 2) * D + xch) = z1; *(f32x4*)(outs + (size_t)(sb * 2 + 1) * D + xch) = z[m]; }
            } else {
#pragma unroll
                for (int m = 0; m < 4; ++m) { const int r = rbase + ai * HALF + 16 * m; const bool hi = r >= rb; const int t = hi ? r - rb : r - b0 * TP, b = hi ? b0 + 1 : b0;
                    f32x4 z1, z2;
#pragma unroll
                    for (int e = 0; e < 4; ++e) { float a1 = dpp_ror1(z[m][e]), a2 = dpp_ror2(z[m][e]);
                        if (m > 0) { const float xp = z[m > 0 ? m - 1 : 0][e]; const float p1 = dpp_ror1(xp), p2 = dpp_ror2(xp); a1 = fr >= 1 ? a1 : p1; a2 = fr >= 2 ? a2 : p2; }
                        if (t == 0) a1 = 0.f; if (t <= 1) a2 = 0.f; z1[e] = a1; z2[e] = a2; }
                    const f32x4 gb = acc[ai][0][m][0], ua = gb * (w0 * z2 + w1 * z1 + w2 * z[m]), ma = acc[ai][1][m][1] + bm;
                    bf16_t* rowp = O + (size_t)r * DP + xch;
                    if (m > 0 || fr >= 2) { u32x2 a; a.x = cvt_pk_bf16(ua[0], ua[1]); a.y = cvt_pk_bf16(ua[2], ua[3]); *(u32x2*)(rowp + C_UA) = a; }
                    { u32x2 g; g.x = cvt_pk_bf16(ma[0], ma[1]); g.y = cvt_pk_bf16(ma[2], ma[3]); *(u32x2*)(rowp + C_MA) = g; }
                    if (m == 0 && fr < 2) { const int blk = r >> 6; u32x2 a; a.x = cvt_pk_bf16(gb[0], gb[1]); a.y = cvt_pk_bf16(gb[2], gb[3]); *(u32x2*)(EFA + ((size_t)(blk * 2 + fr) * 2) * D + xch) = a;
                        u32x2 q; q.x = cvt_pk_bf16(z[0][0], z[0][1]); q.y = cvt_pk_bf16(z[0][2], z[0][3]); *(u32x2*)(EFA + ((size_t)(blk * 2 + fr) * 2 + 1) * D + xch) = q; }
                    if (m == 3 && fr >= 14) { const int blk = r >> 6; u32x2 q; q.x = cvt_pk_bf16(z[3][0], z[3][1]); q.y = cvt_pk_bf16(z[3][2], z[3][3]); *(u32x2*)(ELA + (size_t)(blk * 2 + (fr - 14)) * D + xch) = q; }
                    if (t >= TP - 2) *(f32x4*)(outp + ((size_t)(b * 2) + (t - (TP - 2))) * D + xch) = z[m]; }
            }
        }
    }
};

template <class Epi, bool ALIGN_EPI = true, bool SP2 = true>
__device__ __forceinline__ void gemm_phase(LAS unsigned char* lds, const Gemm g, const Order& S, const Epi& E) {
    const int tid = tid_(), wid = __builtin_amdgcn_readfirstlane(tid >> 6), lane = tid & 63, wr = wid >> 2, wc = wid & 3, fr = lane & 15, fq = lane >> 4;
    const int K = g.K, lda = g.lda;
    unsigned voffA[2], voffB[2];
#pragma unroll
    for (int i = 0; i < 2; ++i) { int R, C; stage_rc(tid * 16 + i * 8192, R, C); const int Rb = Epi::PERM ? ((R & ~31) + perm32(R & 31)) : R;
        voffA[i] = (unsigned)(R * lda + C) * 2u; voffB[i] = (unsigned)(Rb * K + C) * 2u; }
    const size_t kstep = (size_t)(BK * 2);
    const size_t hstepA = (size_t)HALF * lda * 2, hstepB = (size_t)HALF * K * 2;
    const size_t tstepA = 2 * hstepA, tstepB = 2 * hstepB;
    const unsigned ldsw = (unsigned)wid * 1024u;
    const int aoff = lds_byte(wr * 64 + fr, fq * 8), boff = lds_byte(wc * 32 + fr, fq * 8);
#define PG8_SA(b, h) (((b) * 2 + (h)) * HTB)
#define PG8_SB(b, h) ((4 + (b) * 2 + (h)) * HTB)
#define PG8_STAGE(bufoff, gbase, voff) do { _Pragma("unroll") for (int _i = 0; _i < 2; ++_i) \
        __builtin_amdgcn_global_load_lds((const unsigned*)((const char*)(gbase) + (voff)[_i]), (LAS unsigned*)(lds + (bufoff) + ldsw + _i * 8192), 16, 0, 0); } while (0)
#define PG8_LDA(dst, b, h) do { _Pragma("unroll") for (int m = 0; m < 4; ++m) _Pragma("unroll") for (int k = 0; k < 2; ++k) dst[m][k] = *(const LAS bf16x8*)(lds + PG8_SA(b, h) + aoff + m * 2048 + k * 1024); } while (0)
#define PG8_LDB(dst, b, h) do { _Pragma("unroll") for (int n = 0; n < 2; ++n) _Pragma("unroll") for (int k = 0; k < 2; ++k) dst[n][k] = *(const LAS bf16x8*)(lds + PG8_SB(b, h) + boff + n * 2048 + k * 1024); } while (0)
#define PG8_MMA(ai, bj, At, Bt) do { __builtin_amdgcn_s_setprio(1); _Pragma("unroll") for (int m = 0; m < 4; ++m) _Pragma("unroll") for (int n = 0; n < 2; ++n) _Pragma("unroll") for (int k = 0; k < 2; ++k) \
        acc[ai][bj][m][n] = __builtin_amdgcn_mfma_f32_16x16x32_bf16(Bt[n][k], At[m][k], acc[ai][bj][m][n], 0, 0, 0); __builtin_amdgcn_s_setprio(0); } while (0)
#define PG8_WAIT_V(n) asm volatile("s_waitcnt vmcnt(" #n ")" ::: "memory")
#define PG8_WAIT_L(n) asm volatile("s_waitcnt lgkmcnt(" #n ")" ::: "memory")
#define PG8_BAR __builtin_amdgcn_s_barrier()
#define PG8_SCHED __builtin_amdgcn_sched_barrier(0)
    Unit cur, nxt; int ui = 0;
    if (!S.next(0, cur)) return;
    f32x4 acc[2][2][4][2];
#pragma unroll
    for (int a = 0; a < 2; ++a)
#pragma unroll
        for (int b = 0; b < 2; ++b)
#pragma unroll
            for (int m = 0; m < 4; ++m)
#pragma unroll
                for (int n = 0; n < 2; ++n) acc[a][b][m][n] = (f32x4){0.f, 0.f, 0.f, 0.f};
    bf16x8 At[4][2], B0[2][2], B1[2][2];
    const char* cA = (const char*)(cur.z ? g.A1 : g.A0) + (size_t)cur.pm * tstepA + (size_t)cur.kt0 * kstep; const char* cB = (const char*)(cur.z ? g.B1 : g.B0) + (size_t)cur.pn * tstepB + (size_t)cur.kt0 * kstep;
    if constexpr (SP2) {
        PG8_STAGE(PG8_SB(0, 0), cB, voffB); PG8_STAGE(PG8_SB(0, 1), cB + hstepB, voffB); PG8_STAGE(PG8_SA(0, 0), cA, voffA); PG8_STAGE(PG8_SA(0, 1), cA + hstepA, voffA);
        if (wr == 1) PG8_BAR;
        PG8_WAIT_V(2); PG8_BAR;
        PG8_STAGE(PG8_SB(1, 0), cB + kstep, voffB); PG8_STAGE(PG8_SA(1, 0), cA + kstep, voffA); PG8_STAGE(PG8_SB(1, 1), cB + hstepB + kstep, voffB);
        PG8_WAIT_V(6); PG8_BAR;
    } else {
    PG8_STAGE(PG8_SB(0, 0), cB, voffB); PG8_STAGE(PG8_SA(0, 0), cA, voffA); PG8_STAGE(PG8_SB(0, 1), cB + hstepB, voffB); PG8_STAGE(PG8_SA(0, 1), cA + hstepA, voffA);
    if (wr == 1) PG8_BAR;
    PG8_WAIT_V(4); PG8_BAR;
    PG8_STAGE(PG8_SB(1, 0), cB + kstep, voffB); PG8_STAGE(PG8_SA(1, 0), cA + kstep, voffA); PG8_STAGE(PG8_SB(1, 1), cB + hstepB + kstep, voffB);
    PG8_WAIT_V(6); PG8_BAR;
    }
    for (;;) {
        const bool has_next = S.next(ui + 1, nxt);
        const char* nA = has_next ? (const char*)(nxt.z ? g.A1 : g.A0) + (size_t)nxt.pm * tstepA + (size_t)nxt.kt0 * kstep : cA; const char* nB = has_next ? (const char*)(nxt.z ? g.B1 : g.B0) + (size_t)nxt.pn * tstepB + (size_t)nxt.kt0 * kstep : cB;
        const int nt = cur.nkt;
        for (int t = 0; t < nt; t += 2) {
            const bool last = (t == nt - 2);
            const char* a1 = cA + (size_t)(t + 1) * kstep;
            const char* a2 = last ? nA : cA + (size_t)(t + 2) * kstep; const char* b2 = last ? nB : cB + (size_t)(t + 2) * kstep;
            const char* a3 = a2 + kstep; const char* b3 = b2 + kstep;
            if constexpr (SP2) {
            PG8_LDB(B0, 0, 0); PG8_LDB(B1, 0, 1); PG8_SCHED; PG8_LDA(At, 0, 0); PG8_STAGE(PG8_SA(1, 1), a1 + hstepA, voffA);
            PG8_WAIT_V(8); PG8_WAIT_L(0); PG8_BAR; PG8_MMA(0, 0, At, B0); PG8_MMA(0, 1, At, B1); PG8_BAR; PG8_SCHED;
            PG8_LDA(At, 0, 1); PG8_STAGE(PG8_SB(0, 0), b2, voffB); PG8_STAGE(PG8_SB(0, 1), b2 + hstepB, voffB); PG8_STAGE(PG8_SA(0, 0), a2, voffA);
            PG8_WAIT_V(8); PG8_WAIT_L(0); PG8_BAR; PG8_MMA(1, 0, At, B0); PG8_MMA(1, 1, At, B1); PG8_BAR; PG8_SCHED;
            PG8_LDB(B0, 1, 0); PG8_LDB(B1, 1, 1); PG8_SCHED; PG8_LDA(At, 1, 0); PG8_STAGE(PG8_SA(0, 1), a2 + hstepA, voffA);
            PG8_WAIT_V(8); PG8_WAIT_L(0); PG8_BAR; PG8_MMA(0, 0, At, B0); PG8_MMA(0, 1, At, B1); PG8_BAR; PG8_SCHED;
            PG8_LDA(At, 1, 1); PG8_STAGE(PG8_SB(1, 0), b3, voffB); PG8_STAGE(PG8_SB(1, 1), b3 + hstepB, voffB); PG8_STAGE(PG8_SA(1, 0), a3, voffA);
            PG8_WAIT_V(8); PG8_WAIT_L(0); PG8_BAR; PG8_MMA(1, 0, At, B0); PG8_MMA(1, 1, At, B1); PG8_BAR; PG8_SCHED;
            } else {
            PG8_LDB(B0, 0, 0); PG8_SCHED; PG8_LDA(At, 0, 0); PG8_STAGE(PG8_SA(1, 1), a1 + hstepA, voffA);
            PG8_WAIT_L(8); PG8_BAR; PG8_WAIT_L(0); PG8_MMA(0, 0, At, B0); PG8_BAR; PG8_SCHED;
            PG8_LDB(B1, 0, 1); PG8_STAGE(PG8_SB(0, 0), b2, voffB);
            PG8_BAR; PG8_WAIT_L(0); PG8_MMA(0, 1, At, B1); PG8_BAR;
            PG8_LDA(At, 0, 1); PG8_STAGE(PG8_SA(0, 0), a2, voffA);
            PG8_BAR; PG8_WAIT_L(0); PG8_MMA(1, 0, At, B0); PG8_BAR; PG8_SCHED;
            PG8_STAGE(PG8_SB(0, 1), b2 + hstepB, voffB);
            PG8_WAIT_V(6); PG8_BAR; PG8_MMA(1, 1, At, B1); PG8_BAR;
            PG8_LDB(B0, 1, 0); PG8_SCHED; PG8_LDA(At, 1, 0); PG8_STAGE(PG8_SA(0, 1), a2 + hstepA, voffA);
            PG8_WAIT_L(8); PG8_BAR; PG8_WAIT_L(0); PG8_MMA(0, 0, At, B0); PG8_BAR; PG8_SCHED;
            PG8_LDB(B1, 1, 1); PG8_STAGE(PG8_SB(1, 0), b3, voffB);
            PG8_BAR; PG8_WAIT_L(0); PG8_MMA(0, 1, At, B1); PG8_BAR;
            PG8_LDA(At, 1, 1); PG8_STAGE(PG8_SA(1, 0), a3, voffA);
            PG8_BAR; PG8_WAIT_L(0); PG8_MMA(1, 0, At, B0); PG8_BAR; PG8_SCHED;
            PG8_STAGE(PG8_SB(1, 1), b3 + hstepB, voffB);
            PG8_WAIT_V(6); PG8_BAR; PG8_MMA(1, 1, At, B1); PG8_BAR;
            }
        }
        if constexpr (ALIGN_EPI) { if (wr == 0) PG8_BAR; }
        bool chained = false;
        if constexpr (Epi::CHAIN) { if (cur.z == 0 && cur.kt0 == 0 && cur.nkt * BK == K) { E.mid(acc, cur, wr, wc, fr, fq); chained = true; } }
        if (!chained) E(acc, cur, wr, wc, fr, fq);
        if (!has_next) break;
        if (!chained) {
#pragma unroll
        for (int a = 0; a < 2; ++a)
#pragma unroll
            for (int b = 0; b < 2; ++b)
#pragma unroll
                for (int m = 0; m < 4; ++m)
#pragma unroll
                    for (int n = 0; n < 2; ++n) acc[a][b][m][n] = (f32x4){0.f, 0.f, 0.f, 0.f};
        }
        cur = nxt; cA = nA; cB = nB; ++ui;
        if constexpr (ALIGN_EPI) { if (wr == 1) PG8_BAR; }
    }
    PG8_WAIT_V(0);
    if constexpr (!ALIGN_EPI) { if (wr == 0) PG8_BAR; }
    PG8_BAR;
#undef PG8_SA
#undef PG8_SB
#undef PG8_STAGE
#undef PG8_LDA
#undef PG8_LDB
#undef PG8_MMA
#undef PG8_WAIT_V
#undef PG8_WAIT_L
#undef PG8_BAR
#undef PG8_SCHED
}
}

__device__ __forceinline__ int winrow(int n) {
    const int st = n >> 10, ch = n & 1023;
    if (st == 3) return 4096 + ch; if (st == 4) return 5120 + ch; if (st == 6) return 6144 + ch;
    const int s = st == 5 ? 3 : st, j = ch >> 6, w = ch & 63;
    return 256 * j + 128 * (s >> 1) + 32 * (w >> 4) + 8 * ((w & 15) >> 2) + 4 * (s & 1) + (w & 3);
}
__device__ __forceinline__ void transpose_item(const float* W, int K, int N, bf16_t* WT, const float* scale, int item, int lane, int mode) {
    const int nblk = N >> 6, kb = item / nblk, nb = item - kb * nblk, n = 64 * nb + lane, k0 = 64 * kb;
    const int nr = mode == -2 ? winrow(n) : mode < 0 ? n : ((n >> 7) * 256 + (n & 127) + mode);
    const float* src = W + (size_t)k0 * N + n; bf16_t* dst = WT + (size_t)nr * K + k0;
    float v[64];
#pragma unroll
    for (int i = 0; i < 64; ++i) v[i] = __builtin_nontemporal_load(src + (size_t)i * N);
    if (scale) {
#pragma unroll
        for (int i = 0; i < 64; ++i) v[i] *= scale[k0 + i]; }
#pragma unroll
    for (int j = 0; j < 8; ++j) { u32x4 o; o.x = cvt_pk_bf16(v[8 * j], v[8 * j + 1]); o.y = cvt_pk_bf16(v[8 * j + 2], v[8 * j + 3]); o.z = cvt_pk_bf16(v[8 * j + 4], v[8 * j + 5]); o.w = cvt_pk_bf16(v[8 * j + 6], v[8 * j + 7]);
        *(u32x4*)(dst + 8 * j) = o; }
}

__device__ __forceinline__ void convert_phase(KP p, int l, int part, int vcu, int nvcu) {
    const int tid = tid_(), lane = tid & 63, wave = __builtin_amdgcn_readfirstlane(tid >> 6);
    const int gw = vcu * 8 + wave, NGW = nvcu * 8;
    unsigned char* ws = p->ws;
    constexpr int I_IN = 16 * 112, I_SQ = 16 * 16, I_UP = 16 * 44, I_DN = 44 * 16, I_RG = 16;
    constexpr int NIT = I_IN + 3 * I_SQ + 2 * I_UP + I_DN + 2 * I_RG;
    const int lo = part == 0 ? 0 : I_IN, hi = part == 0 ? I_IN : NIT;
    for (int it = lo + gw; it < hi; it += NGW) {
        int r = it;
        if (r < I_IN) { transpose_item(p->in[10] + (size_t)l * D * DIN, D, DIN, (bf16_t*)(ws + WS_WIN), p->in[7] + l * D, r, lane, -2); continue; } r -= I_IN;
        if (r < I_SQ) { transpose_item(p->in[13] + (size_t)l * D * D, D, D, (bf16_t*)(ws + WS_WA), nullptr, r, lane, -1); continue; } r -= I_SQ;
        if (r < I_SQ) { transpose_item(p->in[21] + (size_t)l * D * D, D, D, (bf16_t*)(ws + WS_WB), nullptr, r, lane, -1); continue; } r -= I_SQ;
        if (r < I_SQ) { transpose_item(p->in[22] + (size_t)l * D * D, D, D, (bf16_t*)(ws + WS_WO), nullptr, r, lane, -1); continue; } r -= I_SQ;
        if (r < I_UP) { transpose_item(p->in[23] + (size_t)l * D * DFF, D, DFF, (bf16_t*)(ws + WS_WUG), p->in[8] + l * D, r, lane, 0); continue; } r -= I_UP;
        if (r < I_UP) { transpose_item(p->in[24] + (size_t)l * D * DFF, D, DFF, (bf16_t*)(ws + WS_WUG), p->in[8] + l * D, r, lane, 128); continue; } r -= I_UP;
        if (r < I_DN) { transpose_item(p->in[27] + (size_t)l * DFF * D, DFF, D, (bf16_t*)(ws + WS_WD), nullptr, r, lane, -1); continue; } r -= I_DN;
        if (r < I_RG) { transpose_item(p->in[16] + (size_t)l * 16 * 4096 + r * 4096, 64, 64, (bf16_t*)(ws + WS_RGA) + r * 4096, nullptr, 0, lane, -1); continue; } r -= I_RG;
        transpose_item(p->in[18] + (size_t)l * 16 * 4096 + r * 4096, 64, 64, (bf16_t*)(ws + WS_RGX) + r * 4096, nullptr, 0, lane, -1);
    }
    const int gt = part == 0 ? vcu * 512 + tid : DIN;
    if (gt < DIN) { float bv = 0.f;
        if (gt < 4096) { const int rem = gt & 255, sidx = 2 * (rem >> 7) + ((rem & 7) >> 2), ch = 64 * (gt >> 8) + 16 * ((rem & 127) >> 5) + 4 * ((rem & 31) >> 3) + (rem & 3); if (sidx == 3) bv = p->in[11][l * 2048 + ch]; }
        else if (gt >= 6144) bv = p->in[11][l * 2048 + 1024 + gt - 6144];
        ((float*)(ws + WS_BIASP))[gt] = bv; }
    if (gt < D) { const float x = -p->in[20][l * D + gt]; ((float*)(ws + WS_SP))[gt] = fmaxf(x, 0.f) + log1pf(expf(-fabsf(x))); }
}

__device__ __forceinline__ const float* src_row(KP p, int m) {
    if (m >= MP) return p->in[1] + (size_t)(m - MP) * D;
    const int b = m / TP, t = m - b * TP;
    return t < NMETA ? p->in[6] + (size_t)t * D : p->in[0] + ((size_t)b * SEQ + (t - NMETA)) * D;
}
__device__ __forceinline__ void norm_phase(KP p, bool first, int nslab) {
    const int tid = tid_(), lane = tid & 63, wave = __builtin_amdgcn_readfirstlane(tid >> 6);
    const int gw = bid_() * 8 + wave, NGW = gdim_() * 8;
    bf16_t* X = (bf16_t*)(p->ws + WS_X); bf16_t* XN = (bf16_t*)(p->ws + WS_R2);
    for (int m = gw; m < M; m += NGW) {
        f32x4 v[4]; float s = 0.f;
        if (first) { const f32x4* xr = (const f32x4*)src_row(p, m) + lane;
#pragma unroll
            for (int j = 0; j < 4; ++j) v[j] = __builtin_nontemporal_load(xr + 64 * j); }
        else { const u32x2* xr = (const u32x2*)(X + (size_t)m * D) + lane;
#pragma unroll
            for (int j = 0; j < 4; ++j) { const u32x2 w = xr[64 * j]; v[j] = (f32x4){bflo(w.x), bfhi(w.x), bflo(w.y), bfhi(w.y)}; } }
        const bool fold = (!first) && m >= 64 * 256;
        if (fold) { const f32x4* sl = (const f32x4*)(p->ws + WS_SLAB) + (size_t)(m - 64 * 256) * (D / 4) + lane;
            for (int q = 0; q < nslab; ++q) {
#pragma unroll
                for (int j = 0; j < 4; ++j) v[j] += sl[(size_t)q * 256 * (D / 4) + 64 * j]; } }
        if (first || fold) { u32x2* xo = (u32x2*)(X + (size_t)m * D) + lane;
#pragma unroll
            for (int j = 0; j < 4; ++j) { u32x2 w; w.x = cvt_pk_bf16(v[j][0], v[j][1]); w.y = cvt_pk_bf16(v[j][2], v[j][3]); xo[64 * j] = w; } }
#pragma unroll
        for (int j = 0; j < 4; ++j) s += (v[j][0] * v[j][0] + v[j][1] * v[j][1]) + (v[j][2] * v[j][2] + v[j][3] * v[j][3]);
        const float rinv = rsqrtf(wave_sum(s) * (1.f / D) + EPS);
        u32x2* o8 = (u32x2*)(XN + (size_t)m * D) + lane;
#pragma unroll
        for (int j = 0; j < 4; ++j) { u32x2 w; w.x = cvt_pk_bf16(v[j][0] * rinv, v[j][1] * rinv); w.y = cvt_pk_bf16(v[j][2] * rinv, v[j][3] * rinv); o8[64 * j] = w; }
    }
}
__device__ __forceinline__ void final_norm_phase(KP p) {
    const int tid = tid_(), lane = tid & 63, wave = __builtin_amdgcn_readfirstlane(tid >> 6);
    const int gw = bid_() * 8 + wave, NGW = gdim_() * 8;
    const bf16_t* X = (const bf16_t*)(p->ws + WS_X); const f32x4* gp = (const f32x4*)p->in[9] + lane;
    for (int m = gw; m < M; m += NGW) {
        float* dst;
        if (m >= MP) dst = p->out + O_YS + (size_t)(m - MP) * D;
        else { const int b = m / TP, t = m - b * TP; if (t < NMETA) continue; dst = p->out + O_YP + ((size_t)b * SEQ + (t - NMETA)) * D; }
        const u32x2* xr = (const u32x2*)(X + (size_t)m * D) + lane;
        f32x4 v[4]; float s = 0.f;
#pragma unroll
        for (int j = 0; j < 4; ++j) { const u32x2 w = xr[64 * j]; v[j] = (f32x4){bflo(w.x), bfhi(w.x), bflo(w.y), bfhi(w.y)}; }
        if (m >= 64 * 256) { const f32x4* sl = (const f32x4*)(p->ws + WS_SLAB) + (size_t)(m - 64 * 256) * (D / 4) + lane;
            for (int q = 0; q < 11; ++q) {
#pragma unroll
                for (int j = 0; j < 4; ++j) v[j] += sl[(size_t)q * 256 * (D / 4) + 64 * j]; } }
#pragma unroll
        for (int j = 0; j < 4; ++j) s += (v[j][0] * v[j][0] + v[j][1] * v[j][1]) + (v[j][2] * v[j][2] + v[j][3] * v[j][3]);
        const float rinv = rsqrtf(wave_sum(s) * (1.f / D) + EPS);
        f32x4* o = (f32x4*)dst + lane;
#pragma unroll
        for (int j = 0; j < 4; ++j) __builtin_nontemporal_store(v[j] * rinv * gp[64 * j], o + 64 * j);
    }
}

__device__ __forceinline__ void mixed_fold_phase(KP p) {
    const int tid = tid_(), lane = tid & 63, wave = __builtin_amdgcn_readfirstlane(tid >> 6);
    const int gw = bid_() * 8 + wave, NGW = gdim_() * 8;
    bf16_t* P = (bf16_t*)(p->ws + WS_BIG);
    for (int r = gw; r < 256; r += NGW) {
        const f32x4* sl = (const f32x4*)(p->ws + WS_SLAB) + (size_t)r * (D / 4) + lane;
        f32x4 v[4];
#pragma unroll
        for (int j = 0; j < 4; ++j) v[j] = sl[64 * j];
        for (int q = 1; q < 8; ++q) {
#pragma unroll
            for (int j = 0; j < 4; ++j) v[j] += sl[(size_t)q * 256 * (D / 4) + 64 * j]; }
        u32x2* o8 = (u32x2*)(P + (size_t)(64 * 256 + r) * DP + C_MIX) + lane;
#pragma unroll
        for (int j = 0; j < 4; ++j) { u32x2 w; w.x = cvt_pk_bf16(v[j][0], v[j][1]); w.y = cvt_pk_bf16(v[j][2], v[j][3]); o8[64 * j] = w; }
    }
}

__device__ __forceinline__ void mixa_edge_phase(KP p, int l) {
    bf16_t* P = (bf16_t*)(p->ws + WS_BIG); const bf16_t* EFA = (const bf16_t*)(p->ws + WS_SLAB); const bf16_t* ELA = EFA + (size_t)260 * 2 * 2 * D;
    const int gt = bid_() * 512 + tid_(), NT = gdim_() * 512;
    const float* cw = p->in[12] + (size_t)l * 3 * D;
    for (int it = gt; it < 258 * 2 * 128; it += NT) {
        const int rq = it >> 7, c0 = (it & 127) * 8, q = rq & 1, blk = rq >> 1, r = 64 * blk + q, b = r / TP, t = r - b * TP;
        float w0[8], w1[8], w2[8]; load8f(cw + c0, w0); load8f(cw + D + c0, w1); load8f(cw + 2 * D + c0, w2);
        float gb[8], z0[8], z1[8], z2[8], o[8];
        unpack8(*(const u32x4*)(EFA + ((size_t)(blk * 2 + q) * 2) * D + c0), gb); unpack8(*(const u32x4*)(EFA + ((size_t)(blk * 2 + q) * 2 + 1) * D + c0), z0);
#pragma unroll
        for (int e = 0; e < 8; ++e) { z1[e] = 0.f; z2[e] = 0.f; }
        if (t >= 1) { if (q == 1) unpack8(*(const u32x4*)(EFA + ((size_t)(blk * 2) * 2 + 1) * D + c0), z1); else unpack8(*(const u32x4*)(ELA + (size_t)((blk - 1) * 2 + 1) * D + c0), z1); }
        if (t >= 2) { if (q == 1) unpack8(*(const u32x4*)(ELA + (size_t)((blk - 1) * 2 + 1) * D + c0), z2); else unpack8(*(const u32x4*)(ELA + (size_t)((blk - 1) * 2) * D + c0), z2); }
#pragma unroll
        for (int e = 0; e < 8; ++e) o[e] = gb[e] * (w0[e] * z2[e] + w1[e] * z1[e] + w2[e] * z0[e]);
        *(u32x4*)(P + (size_t)r * DP + C_UA + c0) = pack8(o);
    }
}

template <int NT>
__device__ __forceinline__ void scan_tiles(KP p, int l, const bf16_t* P, bf16_t* HLOC, bf16_t* PCUM, LAS float* XCb, LAS const float* CST, const bf16x8 (&Wa)[4][2], const bf16x8 (&Wx)[4][2],
                                           int b, int hc0, int m0, int lane, int fr, int fq, float (&Hc)[4], float (&Pc)[4]) {
    const int rr = lane >> 2, cl = (lane & 3) * 16;
    u32x4 raw[NT][4][2];
#pragma unroll
    for (int u = 0; u < NT; ++u) { const int m = m0 + 16 * u + rr, t = m - b * TP;
#pragma unroll
        for (int k = 0; k < 4; ++k) {
            if (t - 3 + k >= 0) { const bf16_t* src = P + (size_t)(m - 3 + k) * DP + C_XR + hc0 + cl; raw[u][k][0] = *(const u32x4*)src; raw[u][k][1] = *(const u32x4*)(src + 8); }
            else { raw[u][k][0] = (u32x4){0u, 0u, 0u, 0u}; raw[u][k][1] = (u32x4){0u, 0u, 0u, 0u}; } } }
    LDS_WAIT();
#pragma unroll
    for (int u = 0; u < NT; ++u) { const int m = m0 + 16 * u + rr, t = m - b * TP; LAS float* XC = XCb + u * (16 * 68);
        float xv[4][16];
#pragma unroll
        for (int k = 0; k < 4; ++k) { float f0[8], f1[8]; unpack8(raw[u][k][0], f0); unpack8(raw[u][k][1], f1);
#pragma unroll
            for (int e = 0; e < 8; ++e) { xv[k][e] = f0[e]; xv[k][8 + e] = f1[e]; } }
        if (t >= TP - 3) { float* o = p->out + O_PCB + ((size_t)(l * NB + b) * 3 + (t - (TP - 3))) * D + hc0 + cl;
#pragma unroll
            for (int e = 0; e < 16; e += 4) *(f32x4*)(o + e) = (f32x4){xv[3][e], xv[3][e + 1], xv[3][e + 2], xv[3][e + 3]}; }
#pragma unroll
        for (int e = 0; e < 16; e += 4) {
            const f32x4 w0 = *(const LAS f32x4*)(CST + 0 * 64 + cl + e), w1 = *(const LAS f32x4*)(CST + 1 * 64 + cl + e), w2 = *(const LAS f32x4*)(CST + 2 * 64 + cl + e),
                        w3 = *(const LAS f32x4*)(CST + 3 * 64 + cl + e), bb = *(const LAS f32x4*)(CST + 4 * 64 + cl + e);
            f32x4 r;
#pragma unroll
            for (int q = 0; q < 4; ++q) r[q] = w0[q] * xv[0][e + q] + w1[q] * xv[1][e + q] + w2[q] * xv[2][e + q] + w3[q] * xv[3][e + q] + bb[q];
            *(LAS f32x4*)(XC + rr * 68 + cl + e) = r;
        } }
    LDS_WAIT();
    f32x4 ar[NT][4], ai[NT][4];
#pragma unroll
    for (int u = 0; u < NT; ++u) { const LAS float* XC = XCb + u * (16 * 68);
#pragma unroll
        for (int n = 0; n < 4; ++n) { ar[u][n] = (f32x4){0.f, 0.f, 0.f, 0.f}; ai[u][n] = (f32x4){0.f, 0.f, 0.f, 0.f}; }
#pragma unroll
        for (int s = 0; s < 2; ++s) {
            const f32x4 x0 = *(const LAS f32x4*)(XC + fr * 68 + 32 * s + 8 * fq), x1 = *(const LAS f32x4*)(XC + fr * 68 + 32 * s + 8 * fq + 4);
            u32x4 aw; aw.x = cvt_pk_bf16(x0[0], x0[1]); aw.y = cvt_pk_bf16(x0[2], x0[3]); aw.z = cvt_pk_bf16(x1[0], x1[1]); aw.w = cvt_pk_bf16(x1[2], x1[3]);
            const bf16x8 af = __builtin_bit_cast(bf16x8, aw);
#pragma unroll
            for (int n = 0; n < 4; ++n) { ar[u][n] = __builtin_amdgcn_mfma_f32_16x16x32_bf16(af, Wa[n][s], ar[u][n], 0, 0, 0); ai[u][n] = __builtin_amdgcn_mfma_f32_16x16x32_bf16(af, Wx[n][s], ai[u][n], 0, 0, 0); }
        } }
    float av[NT][4][4], bv[NT][4][4];
#pragma unroll
    for (int u = 0; u < NT; ++u) { const LAS float* XC = XCb + u * (16 * 68); const int t0 = m0 + 16 * u - b * TP;
#pragma unroll
        for (int n = 0; n < 4; ++n) { const int cc = 16 * n + fr;
            const float ba = CST[5 * 64 + cc], bx = CST[6 * 64 + cc], sp = CST[7 * 64 + cc];
#pragma unroll
            for (int j = 0; j < 4; ++j) {
                const float xc = XC[(4 * fq + j) * 68 + cc];
                const float r = sigmoidf_(ar[u][n][j] + ba), ig = sigmoidf_(ai[u][n][j] + bx);
                const float a = __expf(-8.0f * r * sp);
                float mult = sqrtf(fmaxf(1.0f - a * a, 0.f));
                if (t0 + 4 * fq + j == 0) mult = 1.0f;
                av[u][n][j] = a; bv[u][n][j] = mult * ig * xc; } } }
#pragma unroll
    for (int u = 0; u < NT; ++u) {
#pragma unroll
        for (int n = 0; n < 4; ++n) { const int ch = hc0 + 16 * n + fr;
            float hl[4], pl[4];
            hl[0] = bv[u][n][0]; pl[0] = av[u][n][0];
#pragma unroll
            for (int j = 1; j < 4; ++j) { hl[j] = av[u][n][j] * hl[j - 1] + bv[u][n][j]; pl[j] = av[u][n][j] * pl[j - 1]; }
            float He = 0.f, Pe = 1.f;
#pragma unroll
            for (int g = 0; g < 3; ++g) { const float Pg = __shfl(pl[3], fr + 16 * g), Hg = __shfl(hl[3], fr + 16 * g); if (g < fq) { He = Pg * He + Hg; Pe = Pg * Pe; } }
            const float Hin = Pe * Hc[n] + He, Pin = Pe * Pc[n];
            float hf[4], pf[4];
#pragma unroll
            for (int j = 0; j < 4; ++j) { hf[j] = hl[j] + pl[j] * Hin; pf[j] = pl[j] * Pin; }
#pragma unroll
            for (int j = 0; j < 4; ++j) { const size_t o = (size_t)(m0 + 16 * u + 4 * fq + j) * D + ch; HLOC[o] = (bf16_t)(cvt_pk_bf16(hf[j], 0.f) & 0xffffu); PCUM[o] = (bf16_t)(cvt_pk_bf16(pf[j], 0.f) & 0xffffu); }
            Hc[n] = __shfl(hf[3], fr + 48); Pc[n] = __shfl(pf[3], fr + 48);
        } }
}

__device__ __forceinline__ void scan_phase(KP p, int l, LAS unsigned char* lds) {
    const int tid = tid_(), lane = tid & 63, wave = __builtin_amdgcn_readfirstlane(tid >> 6), fr = lane & 15, fq = lane >> 4;
    const int gw = bid_() * 8 + wave, NGW = gdim_() * 8;
    LAS float* XC = (LAS float*)(lds + wave * 16384);
    LAS float* CST = XC + 2 * 16 * 68;
    const bf16_t* P = (const bf16_t*)(p->ws + WS_BIG);
    bf16_t* HLOC = (bf16_t*)(p->ws + WS_R2); bf16_t* PCUM = (bf16_t*)(p->ws + WS_R2 + R2_PCUM);
    float* SUMM = (float*)(p->ws + WS_SUMM);
    const float* SP = (const float*)(p->ws + WS_SP);
    constexpr int NTASK = (128 + 8) * 16;
    for (int task = gw; task < NTASK; task += NGW) {
        const int head = task & 15, ck = task >> 4, hc0 = head * 64;
        LDS_WAIT();
        {
            const int ch = hc0 + lane;
#pragma unroll
            for (int k = 0; k < 4; ++k) CST[k * 64 + lane] = p->in[14][(size_t)(l * 4 + k) * D + ch];
            CST[4 * 64 + lane] = p->in[15][l * D + ch]; CST[5 * 64 + lane] = p->in[17][l * D + ch]; CST[6 * 64 + lane] = p->in[19][l * D + ch]; CST[7 * 64 + lane] = SP[ch];
        }
        bf16x8 Wa[4][2], Wx[4][2];
#pragma unroll
        for (int n = 0; n < 4; ++n)
#pragma unroll
            for (int s = 0; s < 2; ++s) { const size_t o = (size_t)head * 4096 + (16 * n + fr) * 64 + 32 * s + 8 * fq;
                Wa[n][s] = *(const bf16x8*)((const bf16_t*)(p->ws + WS_RGA) + o); Wx[n][s] = *(const bf16x8*)((const bf16_t*)(p->ws + WS_RGX) + o); }
        if (ck < 128) {
            const int b = ck >> 4, q = ck & 15, tile0 = b * 129 + 8 * q;
            float Hc[4], Pc[4];
#pragma unroll
            for (int n = 0; n < 4; ++n) { Hc[n] = 0.f; Pc[n] = 1.f; }
            for (int tt = 0; tt < 8; tt += 2) scan_tiles<2>(p, l, P, HLOC, PCUM, XC, CST, Wa, Wx, b, hc0, (tile0 + tt) * 16, lane, fr, fq, Hc, Pc);
            if (q == 15) scan_tiles<1>(p, l, P, HLOC, PCUM, XC, CST, Wa, Wx, b, hc0, (tile0 + 8) * 16, lane, fr, fq, Hc, Pc);
            if (fq == 0) {
#pragma unroll
                for (int n = 0; n < 4; ++n) { const int ch = hc0 + 16 * n + fr; SUMM[(size_t)ck * 2 * D + ch] = Pc[n]; SUMM[(size_t)ck * 2 * D + D + ch] = Hc[n]; } }
        } else {
            const int m0 = (1032 + (ck - 128)) * 16;
            LDS_WAIT();
            {   const int rr = lane >> 2, cb = lane & 3, cl = cb * 16, m = m0 + rr, sb = m - MP;
                float xv[4][16];
                const float* st = p->in[3] + ((size_t)(l * MS + sb) * 3) * D + hc0 + cl;
#pragma unroll
                for (int k = 0; k < 3; ++k)
#pragma unroll
                    for (int e = 0; e < 16; e += 4) { const f32x4 v = *(const f32x4*)(st + (size_t)k * D + e); xv[k][e] = v[0]; xv[k][e + 1] = v[1]; xv[k][e + 2] = v[2]; xv[k][e + 3] = v[3]; }
                const bf16_t* src = P + (size_t)m * DP + C_XR + hc0 + cl;
                float f0[8], f1[8]; unpack8(*(const u32x4*)src, f0); unpack8(*(const u32x4*)(src + 8), f1);
#pragma unroll
                for (int e = 0; e < 8; ++e) { xv[3][e] = f0[e]; xv[3][8 + e] = f1[e]; }
                float* o = p->out + O_SCB + ((size_t)(l * MS + sb) * 3) * D + hc0 + cl;
#pragma unroll
                for (int k = 0; k < 3; ++k)
#pragma unroll
                    for (int e = 0; e < 16; e += 4) *(f32x4*)(o + (size_t)k * D + e) = (f32x4){xv[k + 1][e], xv[k + 1][e + 1], xv[k + 1][e + 2], xv[k + 1][e + 3]};
#pragma unroll
                for (int e = 0; e < 16; e += 4) {
                    const f32x4 w0 = *(const LAS f32x4*)(CST + 0 * 64 + cl + e), w1 = *(const LAS f32x4*)(CST + 1 * 64 + cl + e), w2 = *(const LAS f32x4*)(CST + 2 * 64 + cl + e),
                                w3 = *(const LAS f32x4*)(CST + 3 * 64 + cl + e), bb = *(const LAS f32x4*)(CST + 4 * 64 + cl + e);
                    f32x4 r;
#pragma unroll
                    for (int q = 0; q < 4; ++q) r[q] = w0[q] * xv[0][e + q] + w1[q] * xv[1][e + q] + w2[q] * xv[2][e + q] + w3[q] * xv[3][e + q] + bb[q];
                    *(LAS f32x4*)(XC + rr * 68 + cl + e) = r;
                }
            }
            LDS_WAIT();
            f32x4 ar[4], ai[4];
#pragma unroll
            for (int n = 0; n < 4; ++n) { ar[n] = (f32x4){0.f, 0.f, 0.f, 0.f}; ai[n] = (f32x4){0.f, 0.f, 0.f, 0.f}; }
#pragma unroll
            for (int s = 0; s < 2; ++s) {
                const f32x4 x0 = *(const LAS f32x4*)(XC + fr * 68 + 32 * s + 8 * fq), x1 = *(const LAS f32x4*)(XC + fr * 68 + 32 * s + 8 * fq + 4);
                u32x4 aw; aw.x = cvt_pk_bf16(x0[0], x0[1]); aw.y = cvt_pk_bf16(x0[2], x0[3]); aw.z = cvt_pk_bf16(x1[0], x1[1]); aw.w = cvt_pk_bf16(x1[2], x1[3]);
                const bf16x8 af = __builtin_bit_cast(bf16x8, aw);
#pragma unroll
                for (int n = 0; n < 4; ++n) { ar[n] = __builtin_amdgcn_mfma_f32_16x16x32_bf16(af, Wa[n][s], ar[n], 0, 0, 0); ai[n] = __builtin_amdgcn_mfma_f32_16x16x32_bf16(af, Wx[n][s], ai[n], 0, 0, 0); }
            }
#pragma unroll
            for (int n = 0; n < 4; ++n) {
                const int cc = 16 * n + fr, ch = hc0 + cc;
                const float ba = CST[5 * 64 + cc], bx = CST[6 * 64 + cc], sp = CST[7 * 64 + cc];
#pragma unroll
                for (int j = 0; j < 4; ++j) {
                    const float xc = XC[(4 * fq + j) * 68 + cc];
                    const float r = sigmoidf_(ar[n][j] + ba), ig = sigmoidf_(ai[n][j] + bx);
                    const float a = __expf(-8.0f * r * sp);
                    const float mult = sqrtf(fmaxf(1.0f - a * a, 0.f));
                    const int sb = m0 - MP + 4 * fq + j;
                    const float h0 = p->in[4][(size_t)(l * MS + sb) * D + ch];
                    const float h = a * h0 + mult * ig * xc;
                    const size_t o = (size_t)(m0 + 4 * fq + j) * D + ch; HLOC[o] = (bf16_t)(cvt_pk_bf16(h, 0.f) & 0xffffu); PCUM[o] = 0;
                    p->out[O_SRG + (size_t)(l * MS + sb) * D + ch] = h; }
            }
        }
    }
}

__device__ __forceinline__ void fixup_phase(KP p, int l) {
    bf16_t* P = (bf16_t*)(p->ws + WS_BIG);
    const bf16_t* HLOC = (const bf16_t*)(p->ws + WS_R2); const bf16_t* PCUM = (const bf16_t*)(p->ws + WS_R2 + R2_PCUM);
    const float* SUMM = (const float*)(p->ws + WS_SUMM);
    const int gt = bid_() * 512 + tid_(), NT = gdim_() * 512;
    for (int it = gt; it < (M / 16) * 128; it += NT) {
        const int tile = it >> 7, c0 = (it & 127) * 8, m0 = tile * 16;
        float carry[8];
#pragma unroll
        for (int e = 0; e < 8; ++e) carry[e] = 0.f;
        int b = 0, t0 = 1;
        if (tile < 1032) {
            b = tile / 129; const int tb = tile - b * 129; int q = tb >> 3; if (q > 15) q = 15; t0 = tb * 16;
            for (int qq = 0; qq < q; ++qq) { float Pq[8], Hq[8]; const float* s = SUMM + (size_t)(b * 16 + qq) * 2 * D + c0; load8f(s, Pq); load8f(s + D, Hq);
#pragma unroll
                for (int e = 0; e < 8; ++e) carry[e] = Pq[e] * carry[e] + Hq[e]; }
        }
#pragma unroll 4
        for (int i = 0; i < 16; ++i) {
            const size_t m = (size_t)(m0 + i);
            float hl[8], pc[8], gr[8], o[8], h[8];
            unpack8(__builtin_nontemporal_load((const u32x4*)(HLOC + m * D + c0)), hl); unpack8(__builtin_nontemporal_load((const u32x4*)(PCUM + m * D + c0)), pc);
            bf16_t* gp = P + m * DP + C_GR + c0; unpack8(*(const u32x4*)gp, gr);
#pragma unroll
            for (int e = 0; e < 8; ++e) { h[e] = hl[e] + pc[e] * carry[e]; o[e] = gelu_tanh(gr[e]) * h[e]; }
            *(u32x4*)gp = pack8(o);
            if (tile < 1032 && t0 + i == TP - 1) store8f(p->out + O_PRG + (size_t)(l * NB + b) * D + c0, h);
        }
    }
}

__device__ __forceinline__ void ffn_edge_phase(KP p, int l) {
    bf16_t* ACT = (bf16_t*)(p->ws + WS_BIG); const bf16_t* EF = (const bf16_t*)(p->ws + WS_SLAB); const bf16_t* EL = EF + (size_t)260 * 2 * 2 * DFF;
    const int gt = bid_() * 512 + tid_(), NT = gdim_() * 512;
    constexpr int NCG = DFF / 8, NIT = 258 * 2 * NCG;
    const float* cw = p->in[25] + (size_t)l * 3 * DFF; const float* cb = p->in[26] + (size_t)l * DFF;
    for (int it = gt; it < NIT; it += NT) {
        const int rq = it / NCG, c0 = (it - rq * NCG) * 8, q = rq & 1, blk = rq >> 1, r = 64 * blk + q, b = r / TP, t = r - b * TP;
        float w0[8], w1[8], w2[8], bb[8]; load8f(cw + c0, w0); load8f(cw + DFF + c0, w1); load8f(cw + 2 * DFF + c0, w2); load8f(cb + c0, bb);
        float u0[8], g0[8], u1[8], u2[8], o[8];
        unpack8(*(const u32x4*)(EF + ((size_t)(blk * 2 + q) * 2) * DFF + c0), u0); unpack8(*(const u32x4*)(EF + ((size_t)(blk * 2 + q) * 2 + 1) * DFF + c0), g0);
#pragma unroll
        for (int e = 0; e < 8; ++e) { u1[e] = 0.f; u2[e] = 0.f; }
        if (t >= 1) { if (q == 1) unpack8(*(const u32x4*)(EF + ((size_t)(blk * 2) * 2) * DFF + c0), u1); else unpack8(*(const u32x4*)(EL + (size_t)((blk - 1) * 2 + 1) * DFF + c0), u1); }
        if (t >= 2) { if (q == 1) unpack8(*(const u32x4*)(EL + (size_t)((blk - 1) * 2 + 1) * DFF + c0), u2); else unpack8(*(const u32x4*)(EL + (size_t)((blk - 1) * 2) * DFF + c0), u2); }
#pragma unroll
        for (int e = 0; e < 8; ++e) { const float uc = w0[e] * u2[e] + w1[e] * u1[e] + w2[e] * u0[e] + bb[e]; o[e] = uc * sigmoidf_(uc) * g0[e]; }
        *(u32x4*)(ACT + (size_t)r * DFF + c0) = pack8(o);
    }
}

#define XB_TMO      128
#define XB_XCNT(j)  (256  + 64 * (j))
#define XB_XSUB(j)  (1280 + 64 * (j))
#define XB_XGEN(j)  (2304 + 64 * (j))
#define XB_TOP      3328
#define XB_TOPGEN   3392
#define XCD_BAR_WORDS 3456
#define XB_SPIN_CAP (1u << 18)
constexpr int LDS_BAR_OFF = 131072, LDS_TOTAL = 131072 + 16;
__device__ __forceinline__ unsigned xb_ld(unsigned* p)              { return __hip_atomic_load(p, __ATOMIC_RELAXED, __HIP_MEMORY_SCOPE_AGENT); }
__device__ __forceinline__ unsigned xb_add(unsigned* p, unsigned v) { return __hip_atomic_fetch_add(p, v, __ATOMIC_RELAXED, __HIP_MEMORY_SCOPE_AGENT); }
__device__ __forceinline__ unsigned xb_xcc_id() { return (unsigned)__builtin_amdgcn_s_getreg((3 << 11) | 20) & 0xFu; }
#define XB_SPIN(cond, bar) do { unsigned _sp = 0; while (cond) { __builtin_amdgcn_s_sleep(1); \
    if ((++_sp & 255u) == 0u) { if (xb_ld(&(bar)[XB_TMO])) break; if (_sp > XB_SPIN_CAP) { atomicAdd(&(bar)[XB_TMO], 1u); break; } } } } while (0)
__device__ __forceinline__ void xcd_barrier_complete(unsigned* bar, unsigned x, unsigned& nloc, unsigned& nx) {
    const unsigned G = gridDim.x;
    unsigned sum, cnt, mine, sp = 0u;
    for (;;) {
        sum = 0u; cnt = 0u; mine = 0u;
#pragma unroll
        for (unsigned j = 0; j < 16; ++j) { const unsigned c = xb_ld(&bar[XB_XCNT(j)]); sum += c; cnt += (c > 0u) ? 1u : 0u; mine = (j == x) ? c : mine; }
        if (sum == G) break;
        __builtin_amdgcn_s_sleep(1);
        if ((++sp & 255u) == 0u) { if (xb_ld(&bar[XB_TMO])) break; if (sp > XB_SPIN_CAP) { atomicAdd(&bar[XB_TMO], 1u); break; } }
    }
    nloc = mine > 0u ? mine : 1u; nx = cnt > 0u ? cnt : 1u;
}
__device__ __forceinline__ void grid_barrier(LAS unsigned char* lds) {
    asm volatile("s_waitcnt vmcnt(0)" ::: "memory");
    __syncthreads();
    if (tid_() == 0) {
        unsigned* bar = (unsigned*)(kargs()->ws + WS_BAR);
        volatile LAS unsigned* st = (volatile LAS unsigned*)(lds + LDS_BAR_OFF);
        const unsigned x = xb_xcc_id();
        __builtin_amdgcn_s_waitcnt(0);
        unsigned nloc = st[0], nx = st[1];
        if (nloc == 0u) { xcd_barrier_complete(bar, x, nloc, nx); st[0] = nloc; st[1] = nx; }
        const unsigned old = xb_add(&bar[XB_XSUB(x)], 1u);
        const unsigned gen = old / nloc;
        if (old + 1u == (gen + 1u) * nloc) {
            __builtin_amdgcn_fence(__ATOMIC_RELEASE, "agent");
            asm volatile("s_waitcnt vmcnt(0)" ::: "memory");
            const unsigned og = xb_add(&bar[XB_TOP], 1u);
            const unsigned tg = og / nx;
            if (og + 1u == (tg + 1u) * nx) xb_add(&bar[XB_TOPGEN], 1u);
            else XB_SPIN(xb_ld(&bar[XB_TOPGEN]) == tg, bar);
            __builtin_amdgcn_fence(__ATOMIC_ACQUIRE, "agent");
            xb_add(&bar[XB_XGEN(x)], 1u);
            asm volatile("s_waitcnt vmcnt(0)" ::: "memory");
        } else {
            XB_SPIN(xb_ld(&bar[XB_XGEN(x)]) == gen, bar);
            __builtin_amdgcn_fence(__ATOMIC_ACQUIRE, "agent");
            asm volatile("s_waitcnt vmcnt(0)" ::: "memory");
        }
    }
    __syncthreads();
}

__global__ void __launch_bounds__(512, 2) fwd_megakernel(Params pv) {
    extern __shared__ __attribute__((aligned(16))) unsigned char shm[];
    LAS unsigned char* lds = (LAS unsigned char*)shm;
    cg::grid_group grid = cg::this_grid();
    if (tid_() < 4) ((LAS unsigned*)(lds + LDS_BAR_OFF))[tid_()] = 0u;
    __syncthreads();
    if (tid_() == 0) (void)xb_add(&((unsigned*)(kargs()->ws + WS_BAR))[XB_XCNT(xb_xcc_id())], 1u);
    grid.sync();
    for (int l = 0; l < DEPTH; ++l) {
        if (l == 0) convert_phase(kargs(), 0, 0, bid_(), gdim_());
        norm_phase(kargs(), l == 0, 11);
        grid_barrier(lds);
        { KP p = kargs(); unsigned char* ws = p->ws; pg8::Gemm g{(const bf16_t*)(ws + WS_R2), nullptr, (const bf16_t*)(ws + WS_WIN), nullptr, D, D}; pg8::Order S; S.init(M, DIN, D, gdim_(), bid_(), 1, 0);
          pg8::EpiProj E{(bf16_t*)(ws + WS_BIG), (const float*)(ws + WS_BIASP), (bf16_t*)(ws + WS_SLAB), (bf16_t*)(ws + WS_SLAB) + (size_t)260 * 2 * 2 * D, p->in[12] + (size_t)l * 3 * D,
                         p->in[2] + (size_t)l * MS * 2 * D, p->out + O_PCA + (size_t)l * NB * 2 * D, p->out + O_SCA + (size_t)l * MS * 2 * D};
          pg8::gemm_phase(lds, g, S, E); }
        if (bid_() >= 28) convert_phase(kargs(), l, 1, bid_() - 28, gdim_() - 28);
        grid_barrier(lds);
        mixa_edge_phase(kargs(), l);
        scan_phase(kargs(), l, lds);
        grid_barrier(lds);
        fixup_phase(kargs(), l);
        grid_barrier(lds);
        { unsigned char* ws = kargs()->ws; bf16_t* BIG = (bf16_t*)(ws + WS_BIG);
          pg8::Gemm g{BIG + C_UA, BIG + C_GR, (const bf16_t*)(ws + WS_WA), (const bf16_t*)(ws + WS_WB), DP, D}; pg8::Order S; S.init(M, D, D, gdim_(), bid_(), 2, 4);
          pg8::EpiAB E{BIG, (float*)(ws + WS_SLAB), D / 64}; pg8::gemm_phase(lds, g, S, E); }
        grid_barrier(lds);
        mixed_fold_phase(kargs());
        grid_barrier(lds);
        { unsigned char* ws = kargs()->ws; pg8::Gemm g{(const bf16_t*)(ws + WS_BIG) + C_MIX, nullptr, (const bf16_t*)(ws + WS_WO), nullptr, DP, D}; pg8::Order S; S.init(M, D, D, gdim_(), bid_(), 1, 4);
          pg8::EpiRes E{(bf16_t*)(ws + WS_X), (float*)(ws + WS_SLAB), D / 64}; pg8::gemm_phase(lds, g, S, E); }
        grid_barrier(lds);
        norm_phase(kargs(), false, 4);
        grid_barrier(lds);
        { KP p = kargs(); unsigned char* ws = p->ws; pg8::Gemm g{(const bf16_t*)(ws + WS_R2), nullptr, (const bf16_t*)(ws + WS_WUG), nullptr, D, D}; pg8::Order S; S.init(M, DUG, D, gdim_(), bid_(), 1, 0);
          pg8::EpiFfn E{(bf16_t*)(ws + WS_BIG), (bf16_t*)(ws + WS_SLAB), (bf16_t*)(ws + WS_SLAB) + (size_t)260 * 2 * 2 * DFF, p->in[25] + (size_t)l * 3 * DFF, p->in[26] + (size_t)l * DFF,
                        p->in[5] + (size_t)l * MS * 2 * DFF, p->out + O_PCF + (size_t)l * NB * 2 * DFF, p->out + O_SCF + (size_t)l * MS * 2 * DFF};
          pg8::gemm_phase(lds, g, S, E); }
        if (l + 1 < DEPTH && bid_() >= 150) convert_phase(kargs(), l + 1, 0, bid_() - 150, gdim_() - 150);
        grid_barrier(lds);
        ffn_edge_phase(kargs(), l);
        grid_barrier(lds);
        { unsigned char* ws = kargs()->ws; pg8::Gemm g{(const bf16_t*)(ws + WS_BIG), nullptr, (const bf16_t*)(ws + WS_WD), nullptr, DFF, DFF}; pg8::Order S; S.init(M, D, DFF, gdim_(), bid_(), 1, 11);
          pg8::EpiRes E{(bf16_t*)(ws + WS_X), (float*)(ws + WS_SLAB), DFF / 64}; pg8::gemm_phase(lds, g, S, E); }
        grid_barrier(lds);
    }
    final_norm_phase(kargs());
}

extern "C" void kernel_launch(void* const* d_in, const int* in_sizes, int n_in, void* d_out, int out_size, void* d_ws, size_t ws_size, hipStream_t stream) {
    static int grid = 0;
    if (grid == 0) {
        if (n_in != 28 || (size_t)out_size != O_END || ws_size < WS_END) { fprintf(stderr, "kernel_launch: unexpected shapes: n_in %d out %d ws %zu (need %zu)\n", n_in, out_size, ws_size, (size_t)WS_END); grid = -1; return; }
        int dev = 0, cus = 0, per_cu = 0;
        hipGetDevice(&dev); hipDeviceGetAttribute(&cus, hipDeviceAttributeMultiprocessorCount, dev);
        if (hipFuncSetAttribute((const void*)fwd_megakernel, hipFuncAttributeMaxDynamicSharedMemorySize, LDS_TOTAL) != hipSuccess) { fprintf(stderr, "kernel_launch: hipFuncSetAttribute failed\n"); grid = -1; return; }
        hipOccupancyMaxActiveBlocksPerMultiprocessor(&per_cu, (const void*)fwd_megakernel, 512, LDS_TOTAL);
        if (per_cu < 1) { fprintf(stderr, "kernel_launch: occupancy query says %d blocks per CU\n", per_cu); (void)hipGetLastError(); per_cu = 1; }
        grid = cus;
    }
    if (grid < 0) return;
    Params p{};
    for (int i = 0; i < 28; ++i) p.in[i] = (const float*)d_in[i];
    p.out = (float*)d_out; p.ws = (unsigned char*)d_ws;
    void* args[] = {&p};
    if (hipMemsetAsync((char*)d_ws + WS_BAR, 0, 16384, stream) != hipSuccess) { fprintf(stderr, "kernel_launch: memset of the barrier words failed\n"); return; }
    hipError_t e = hipLaunchCooperativeKernel((const void*)fwd_megakernel, dim3(grid), dim3(512), args, LDS_TOTAL, stream);
    if (e != hipSuccess) fprintf(stderr, "cooperative launch failed: %s (grid %d)\n", hipGetErrorString(e), grid);
}
```

```cpp
#include <hip/hip_runtime.h>
#include <hip/hip_cooperative_groups.h>
#include <cstdio>
namespace cg = cooperative_groups;

#define LAS __attribute__((address_space(3)))
typedef unsigned short bf16_t;
typedef short bf16x8 __attribute__((ext_vector_type(8)));
typedef float f32x4 __attribute__((ext_vector_type(4)));
typedef float f32x2 __attribute__((ext_vector_type(2)));
typedef unsigned u32x4 __attribute__((ext_vector_type(4)));
typedef unsigned u32x2 __attribute__((ext_vector_type(2)));

constexpr int D = 1024, DIN = 7168, DFF = 2816, DUG = 5632, NB = 8, TP = 2064, MP = NB * TP, MS = 128, M = MP + MS, DEPTH = 4, NMETA = 16, SEQ = 2048;
constexpr float EPS = 1e-6f;
constexpr int DP = 5120, C_UA = 0, C_MA = 1024, C_XR = 2048, C_GR = 3072, C_MB = 4096, C_MIX = 2048;
constexpr size_t O_YP = 0, O_YS = O_YP + (size_t)NB * SEQ * D, O_PCA = O_YS + (size_t)MS * D, O_PCB = O_PCA + (size_t)DEPTH * NB * 2 * D,
                 O_PRG = O_PCB + (size_t)DEPTH * NB * 3 * D, O_PCF = O_PRG + (size_t)DEPTH * NB * D, O_SCA = O_PCF + (size_t)DEPTH * NB * 2 * DFF,
                 O_SCB = O_SCA + (size_t)DEPTH * MS * 2 * D, O_SRG = O_SCB + (size_t)DEPTH * MS * 3 * D, O_SCF = O_SRG + (size_t)DEPTH * MS * D,
                 O_END = O_SCF + (size_t)DEPTH * MS * 2 * DFF;
constexpr size_t al256(size_t x) { return (x + 255) & ~(size_t)255; }
constexpr size_t WS_WIN = 0, WS_WA = WS_WIN + (size_t)DIN * D * 2, WS_WB = WS_WA + (size_t)D * D * 2, WS_WO = WS_WB + (size_t)D * D * 2,
                 WS_WUG = WS_WO + (size_t)D * D * 2, WS_WD = WS_WUG + (size_t)DUG * D * 2, WS_RGA = WS_WD + (size_t)D * DFF * 2, WS_RGX = WS_RGA + 16 * 64 * 64 * 2,
                 WS_BIASP = WS_RGX + 16 * 64 * 64 * 2, WS_SP = WS_BIASP + (size_t)DIN * 4, WS_SUMM = WS_SP + (size_t)D * 4,
                 WS_X = al256(WS_SUMM + (size_t)128 * 2 * D * 4), WS_BIG = WS_X + (size_t)M * D * 4, WS_R2 = WS_BIG + (size_t)M * DIN * 2,
                 WS_BAR = WS_R2 + (size_t)M * DFF * 2, WS_SLAB = WS_BAR + 16384, WS_END = WS_SLAB + (size_t)11 * 256 * D * 4;
constexpr size_t R2_PCUM = (size_t)M * D * 2;

struct Params {
    const float* in[28];
    float* out;
    unsigned char* ws;
};

typedef const Params __attribute__((address_space(4)))* KP;
__device__ __forceinline__ KP kargs() { KP k = (KP)__builtin_amdgcn_kernarg_segment_ptr(); asm volatile("" : "+s"(k)); return k; }

__device__ __forceinline__ int tid_() { int t = threadIdx.x; asm volatile("" : "+v"(t)); return t; }
__device__ __forceinline__ int bid_() { int t = blockIdx.x; asm volatile("" : "+s"(t)); return t; }
__device__ __forceinline__ int gdim_() { int t = gridDim.x; asm volatile("" : "+s"(t)); return t; }

__device__ __forceinline__ unsigned cvt_pk_bf16(float lo, float hi) { unsigned r; asm volatile("v_cvt_pk_bf16_f32 %0, %1, %2" : "=v"(r) : "v"(lo), "v"(hi)); return r; }
__device__ __forceinline__ float bflo(unsigned w) { return __uint_as_float(w << 16); }
__device__ __forceinline__ float bfhi(unsigned w) { return __uint_as_float(w & 0xffff0000u); }
__device__ __forceinline__ void unpack8(const u32x4 v, float (&f)[8]) {
    f[0] = bflo(v.x); f[1] = bfhi(v.x); f[2] = bflo(v.y); f[3] = bfhi(v.y); f[4] = bflo(v.z); f[5] = bfhi(v.z); f[6] = bflo(v.w); f[7] = bfhi(v.w);
}
__device__ __forceinline__ u32x4 pack8(const float (&f)[8]) { u32x4 o; o.x = cvt_pk_bf16(f[0], f[1]); o.y = cvt_pk_bf16(f[2], f[3]); o.z = cvt_pk_bf16(f[4], f[5]); o.w = cvt_pk_bf16(f[6], f[7]); return o; }
__device__ __forceinline__ float sigmoidf_(float x) { return __builtin_amdgcn_rcpf(1.0f + __expf(-x)); }
__device__ __forceinline__ float gelu_tanh(float x) { return x * sigmoidf_(1.5957691216057308f * (x + 0.044715f * x * x * x)); }
__device__ __forceinline__ float wave_sum(float v) {
#pragma unroll
    for (int o = 1; o < 64; o <<= 1) v += __shfl_xor(v, o);
    return v;
}
__device__ __forceinline__ void load8f(const float* p, float (&f)[8]) { const f32x4 a = *(const f32x4*)p, b = *(const f32x4*)(p + 4); f[0] = a[0]; f[1] = a[1]; f[2] = a[2]; f[3] = a[3]; f[4] = b[0]; f[5] = b[1]; f[6] = b[2]; f[7] = b[3]; }
__device__ __forceinline__ void store8f(float* p, const float (&f)[8]) { *(f32x4*)p = (f32x4){f[0], f[1], f[2], f[3]}; *(f32x4*)(p + 4) = (f32x4){f[4], f[5], f[6], f[7]}; }
#define LDS_WAIT() asm volatile("s_waitcnt lgkmcnt(0)" ::: "memory")

namespace pg8 {
constexpr int BM = 256, BK = 64, HALF = 128, HTB = HALF * BK * 2, STAGE_BYTES = 8 * HTB, NXCD = 8, WGM = 8;
__device__ __forceinline__ int lds_byte(int r, int c) { const int st = (r >> 4) * 2 + (c >> 5), rr = r & 15, cc = c & 31, ob = rr * 64 + cc * 2; return st * 1024 + (ob ^ (((ob >> 9) & 1) << 5)); }
__device__ __forceinline__ void stage_rc(int b, int& R, int& C) { const int st = b / 1024, sb = b % 1024, swz = sb ^ (((sb >> 9) & 1) << 5); R = (st >> 1) * 16 + swz / 64; C = (st & 1) * 32 + (swz % 64) / 2; }
__device__ __forceinline__ int perm32(int rho) { const int n = rho >> 4, i = rho & 15; return 8 * (i >> 2) + 4 * n + (i & 3); }

struct Unit { int pm, pn, z, kt0, nkt; };
struct Gemm { const bf16_t* A0; const bf16_t* A1; const bf16_t* B0; const bf16_t* B1; int lda, K; };
struct Order {
    int nM, nN, nwg, G, c, nZ, splitS, ntFull, nmain;
    __device__ void init(int M_, int N_, int K_, int G_, int c_, int nZ_, int splitS_) { nM = M_ / BM; nN = N_ / BM; splitS = splitS_; if (splitS) nM -= 1; nwg = nM * nN; G = G_; c = c_; nZ = nZ_; ntFull = K_ / BK;
        nmain = c < nwg ? (nwg - c + G - 1) / G : 0; }
    __device__ bool next(int i, Unit& u) const {
        if (i < nZ * nmain) {
            const int ti = (nZ == 2) ? (i >> 1) : i;
            int wgid = ti * G + c; { const int q = nwg / NXCD, r = nwg % NXCD, xcd = wgid % NXCD, off = wgid / NXCD; wgid = (xcd < r ? xcd * (q + 1) : r * (q + 1) + (xcd - r) * q) + off; }
            const int nig = WGM * nN, gid = wgid / nig, fm = gid * WGM, gsz = (nM - fm) < WGM ? (nM - fm) : WGM;
            u.pm = fm + ((wgid % nig) % gsz); u.pn = (wgid % nig) / gsz; u.z = (nZ == 2) ? (i & 1) : 0; u.kt0 = 0; u.nkt = ntFull; return true;
        }
        if (!splitS) return false;
        const int e = (i - nZ * nmain) * G + c; if (e >= nN * nZ * splitS) return false;
        u.pm = nM; u.pn = e % nN; const int zs = e / nN; u.z = (nZ == 2) ? (zs & 1) : 0; u.kt0 = ((nZ == 2) ? (zs >> 1) : zs) * 4; u.nkt = 4; return true;
    }
};

struct EpiBf16 {
    static constexpr bool PERM = true, CHAIN = false;
    bf16_t* O; int ldc; const float* bias;
    __device__ __forceinline__ void operator()(const f32x4 (&acc)[2][2][4][2], const Unit& u, int wr, int wc, int fr, int fq) const {
        const int row0 = u.pm * BM + wr * 64 + fr, col0 = u.pn * BM + wc * 32 + 8 * fq;
        f32x4 bv[2][2];
#pragma unroll
        for (int bj = 0; bj < 2; ++bj)
#pragma unroll
            for (int n = 0; n < 2; ++n) bv[bj][n] = bias ? *(const f32x4*)(bias + col0 + bj * HALF + 4 * n) : (f32x4){0.f, 0.f, 0.f, 0.f};
#pragma unroll
        for (int ai = 0; ai < 2; ++ai)
#pragma unroll
            for (int m = 0; m < 4; ++m) { bf16_t* rowp = O + (size_t)(row0 + ai * HALF + m * 16) * ldc + col0;
#pragma unroll
                for (int bj = 0; bj < 2; ++bj) { const f32x4 v0 = acc[ai][bj][m][0] + bv[bj][0], v1 = acc[ai][bj][m][1] + bv[bj][1];
                    u32x4 w; w.x = cvt_pk_bf16(v0[0], v0[1]); w.y = cvt_pk_bf16(v0[2], v0[3]); w.z = cvt_pk_bf16(v1[0], v1[1]); w.w = cvt_pk_bf16(v1[2], v1[3]);
                    *(u32x4*)(rowp + bj * HALF) = w; } }
    }
};
struct EpiRes {
    static constexpr bool PERM = true, CHAIN = false;
    bf16_t* X; float* SLAB; int ntFull;
    __device__ __forceinline__ void operator()(const f32x4 (&acc)[2][2][4][2], const Unit& u, int wr, int wc, int fr, int fq) const {
        const int row0 = u.pm * BM + wr * 64 + fr, col0 = u.pn * BM + wc * 32 + 8 * fq;
        if (u.nkt == ntFull) {
#pragma unroll
            for (int ai = 0; ai < 2; ++ai)
#pragma unroll
                for (int m = 0; m < 4; ++m) { bf16_t* rowp = X + (size_t)(row0 + ai * HALF + m * 16) * D + col0;
#pragma unroll
                    for (int bj = 0; bj < 2; ++bj) { u32x4* p = (u32x4*)(rowp + bj * HALF); float x[8]; unpack8(*p, x); const f32x4 a0 = acc[ai][bj][m][0], a1 = acc[ai][bj][m][1];
#pragma unroll
                        for (int e = 0; e < 4; ++e) { x[e] += a0[e]; x[4 + e] += a1[e]; }
                        *p = pack8(x); }
                    asm volatile("" ::: "memory"); }
        } else {
            float* S0 = SLAB + (size_t)(u.kt0 >> 2) * 256 * D;
#pragma unroll
            for (int ai = 0; ai < 2; ++ai)
#pragma unroll
                for (int m = 0; m < 4; ++m) { float* rowp = S0 + (size_t)(wr * 64 + fr + ai * HALF + m * 16) * D + col0;
#pragma unroll
                    for (int bj = 0; bj < 2; ++bj) { *(f32x4*)(rowp + bj * HALF) = acc[ai][bj][m][0]; *(f32x4*)(rowp + bj * HALF + 4) = acc[ai][bj][m][1]; } }
        }
    }
};
struct EpiAB {
    static constexpr bool PERM = true, CHAIN = true;
    bf16_t* P; float* SLAB; int ntFull;
    __device__ __forceinline__ void mid(f32x4 (&acc)[2][2][4][2], const Unit& u, int wr, int wc, int fr, int fq) const {
        const int row0 = u.pm * BM + wr * 64 + fr, col0 = u.pn * BM + wc * 32 + 8 * fq;
#pragma unroll
        for (int ai = 0; ai < 2; ++ai)
#pragma unroll
            for (int m = 0; m < 4; ++m) { const bf16_t* prow = P + (size_t)(row0 + ai * HALF + m * 16) * DP;
#pragma unroll
                for (int bj = 0; bj < 2; ++bj) { const int c = col0 + bj * HALF;
                    float ga[8], gb[8]; unpack8(__builtin_nontemporal_load((const u32x4*)(prow + C_MA + c)), ga); unpack8(*(const u32x4*)(prow + C_MB + c), gb);
#pragma unroll
                    for (int e = 0; e < 4; ++e) { acc[ai][bj][m][0][e] *= (1.0f + __expf(-gb[e])) * __builtin_amdgcn_rcpf(1.0f + __expf(-ga[e]));
                                                  acc[ai][bj][m][1][e] *= (1.0f + __expf(-gb[4 + e])) * __builtin_amdgcn_rcpf(1.0f + __expf(-ga[4 + e])); } }
                asm volatile("" ::: "memory"); }
    }
    __device__ __forceinline__ void operator()(const f32x4 (&acc)[2][2][4][2], const Unit& u, int wr, int wc, int fr, int fq) const {
        const int row0 = u.pm * BM + wr * 64 + fr, col0 = u.pn * BM + wc * 32 + 8 * fq;
        const bool split = u.nkt != ntFull;
        const int goff = (split && u.z == 0) ? C_MA : C_MB;
        float* S0 = SLAB + (size_t)((u.kt0 >> 2) * 2 + u.z) * 256 * D;
#pragma unroll
        for (int ai = 0; ai < 2; ++ai)
#pragma unroll
            for (int m = 0; m < 4; ++m) { const size_t r = (size_t)(row0 + ai * HALF + m * 16); bf16_t* prow = P + r * DP;
                float* srow = S0 + (size_t)(wr * 64 + fr + ai * HALF + m * 16) * D;
#pragma unroll
                for (int bj = 0; bj < 2; ++bj) { const int c = col0 + bj * HALF;
                    const u32x4 gw = *(const u32x4*)(prow + goff + c); float g[8]; unpack8(gw, g);
                    const f32x4 v0 = acc[ai][bj][m][0], v1 = acc[ai][bj][m][1];
                    float o[8];
#pragma unroll
                    for (int e = 0; e < 4; ++e) { o[e] = sigmoidf_(g[e]) * v0[e]; o[4 + e] = sigmoidf_(g[4 + e]) * v1[e]; }
                    if (split) store8f(srow + c, o); else *(u32x4*)(prow + C_MIX + c) = pack8(o); }
                asm volatile("" ::: "memory"); }
    }
};

__device__ __forceinline__ float dpp_ror1(float x) { return __builtin_bit_cast(float, __builtin_amdgcn_update_dpp(0, __builtin_bit_cast(int, x), 0x121, 0xf, 0xf, false)); }
__device__ __forceinline__ float dpp_ror2(float x) { return __builtin_bit_cast(float, __builtin_amdgcn_update_dpp(0, __builtin_bit_cast(int, x), 0x122, 0xf, 0xf, false)); }
struct EpiFfn {
    static constexpr bool PERM = true, CHAIN = false;
    bf16_t* ACT; bf16_t* EF; bf16_t* EL; const float* cw; const float* cb; const float* st; float* outp; float* outs;
    __device__ __forceinline__ void operator()(const f32x4 (&acc)[2][2][4][2], const Unit& u, int wr, int wc, int fr, int fq) const {
        const int ch0 = u.pn * 128 + wc * 32 + 8 * fq;
        float w0[8], w1[8], w2[8], bb[8]; load8f(cw + ch0, w0); load8f(cw + DFF + ch0, w1); load8f(cw + 2 * DFF + ch0, w2); load8f(cb + ch0, bb);
        const int rbase = u.pm * BM + wr * 64 + fr;
        const int b0 = (u.pm * BM) / TP, rb = (b0 + 1) * TP;
#pragma unroll
        for (int ai = 0; ai < 2; ++ai) {
            if (u.pm == 64 && ai == 1) {
#pragma unroll
                for (int m = 0; m < 4; ++m) { const int r = rbase + HALF + 16 * m, sb = r - MP;
                    float u2[8], u1[8], o[8], uu[8]; load8f(st + (size_t)(sb * 2) * DFF + ch0, u2); load8f(st + (size_t)(sb * 2 + 1) * DFF + ch0, u1);
#pragma unroll
                    for (int k = 0; k < 8; ++k) { const float x = acc[1][0][m][k >> 2][k & 3], g = acc[1][1][m][k >> 2][k & 3]; uu[k] = x;
                        const float uc = w0[k] * u2[k] + w1[k] * u1[k] + w2[k] * x + bb[k]; o[k] = uc * sigmoidf_(uc) * g; }
                    *(u32x4*)(ACT + (size_t)r * DFF + ch0) = pack8(o);
                    store8f(outs + (size_t)(sb * 2) * DFF + ch0, u1); store8f(outs + (size_t)(sb * 2 + 1) * DFF + ch0, uu); }
            } else {
#pragma unroll
                for (int m = 0; m < 4; ++m) { const int r = rbase + ai * HALF + 16 * m; const bool hi = r >= rb; const int t = hi ? r - rb : r - b0 * TP, b = hi ? b0 + 1 : b0;
                    float o[8], uu[8], gg[8];
#pragma unroll
                    for (int k = 0; k < 8; ++k) { const float x = acc[ai][0][m][k >> 2][k & 3], g = acc[ai][1][m][k >> 2][k & 3]; uu[k] = x; gg[k] = g;
                        float u1 = dpp_ror1(x), u2 = dpp_ror2(x);
                        if (m > 0) { const float xp = acc[ai][0][m > 0 ? m - 1 : 0][k >> 2][k & 3]; const float p1 = dpp_ror1(xp), p2 = dpp_ror2(xp); u1 = fr >= 1 ? u1 : p1; u2 = fr >= 2 ? u2 : p2; }
                        if (t == 0) u1 = 0.f; if (t <= 1) u2 = 0.f;
                        const float uc = w0[k] * u2 + w1[k] * u1 + w2[k] * x + bb[k]; o[k] = uc * sigmoidf_(uc) * g; }
                    if (m > 0 || fr >= 2) *(u32x4*)(ACT + (size_t)r * DFF + ch0) = pack8(o);
                    if (m == 0 && fr < 2) { const int blk = r >> 6; *(u32x4*)(EF + ((size_t)(blk * 2 + fr) * 2) * DFF + ch0) = pack8(uu); *(u32x4*)(EF + ((size_t)(blk * 2 + fr) * 2 + 1) * DFF + ch0) = pack8(gg); }
                    if (m == 3 && fr >= 14) { const int blk = r >> 6; *(u32x4*)(EL + (size_t)(blk * 2 + (fr - 14)) * DFF + ch0) = pack8(uu); }
                    if (t >= TP - 2) store8f(outp + ((size_t)(b * 2) + (t - (TP - 2))) * DFF + ch0, uu); }
            }
        }
    }
};

struct EpiProj {
    static constexpr bool PERM = true, CHAIN = false;
    bf16_t* O; const float* bias; bf16_t* EFA; bf16_t* ELA; const float* cw; const float* st; float* outp; float* outs;
    __device__ __forceinline__ void operator()(const f32x4 (&acc)[2][2][4][2], const Unit& u, int wr, int wc, int fr, int fq) const {
        const int rbase = u.pm * BM + wr * 64 + fr;
        if (u.pn >= 16) {
            const int col0 = u.pn * BM + wc * 32 + 8 * fq;
            f32x4 bv[2][2];
#pragma unroll
            for (int bj = 0; bj < 2; ++bj)
#pragma unroll
                for (int n = 0; n < 2; ++n) bv[bj][n] = *(const f32x4*)(bias + col0 + bj * HALF + 4 * n);
#pragma unroll
            for (int ai = 0; ai < 2; ++ai)
#pragma unroll
                for (int m = 0; m < 4; ++m) { bf16_t* rowp = O + (size_t)(rbase + ai * HALF + m * 16) * DP + (col0 - 2048);
#pragma unroll
                    for (int bj = 0; bj < 2; ++bj) { const f32x4 v0 = acc[ai][bj][m][0] + bv[bj][0], v1 = acc[ai][bj][m][1] + bv[bj][1];
                        u32x4 w; w.x = cvt_pk_bf16(v0[0], v0[1]); w.y = cvt_pk_bf16(v0[2], v0[3]); w.z = cvt_pk_bf16(v1[0], v1[1]); w.w = cvt_pk_bf16(v1[2], v1[3]);
                        *(u32x4*)(rowp + bj * HALF) = w; } }
            return;
        }
        const int xch = u.pn * 64 + wc * 16 + 4 * fq;
        const f32x4 w0 = *(const f32x4*)(cw + xch), w1 = *(const f32x4*)(cw + D + xch), w2 = *(const f32x4*)(cw + 2 * D + xch);
        const f32x4 bm = *(const f32x4*)(bias + u.pn * BM + HALF + wc * 32 + 8 * fq + 4);
        const int b0 = (u.pm * BM) / TP, rb = (b0 + 1) * TP;
#pragma unroll
        for (int ai = 0; ai < 2; ++ai) {
            f32x4 z[4];
#pragma unroll
            for (int m = 0; m < 4; ++m) z[m] = acc[ai][0][m][1] * acc[ai][1][m][0];
            if (u.pm == 64 && ai == 1) {
#pragma unroll
                for (int m = 0; m < 4; ++m) { const int r = rbase + HALF + 16 * m, sb = r - MP;
                    const f32x4 z2 = *(const f32x4*)(st + (size_t)(sb * 2) * D + xch), z1 = *(const f32x4*)(st + (size_t)(sb * 2 + 1) * D + xch);
                    const f32x4 ua = acc[1][0][m][0] * (w0 * z2 + w1 * z1 + w2 * z[m]), ma = acc[1][1][m][1] + bm;
                    bf16_t* rowp = O + (size_t)r * DP + xch;
                    u32x2 a; a.x = cvt_pk_bf16(ua[0], ua[1]); a.y = cvt_pk_bf16(ua[2], ua[3]); *(u32x2*)(rowp + C_UA) = a;
                    u32x2 g; g.x = cvt_pk_bf16(ma[0], ma[1]); g.y = cvt_pk_bf16(ma[2], ma[3]); *(u32x2*)(rowp + C_MA) = g;
                    *(f32x4*)(outs + (size_t)(sb * 2) * D + xch) = z1; *(f32x4*)(outs + (size_t)(sb * 2 + 1) * D + xch) = z[m]; }
            } else {
#pragma unroll
                for (int m = 0; m < 4; ++m) { const int r = rbase + ai * HALF + 16 * m; const bool hi = r >= rb; const int t = hi ? r - rb : r - b0 * TP, b = hi ? b0 + 1 : b0;
                    f32x4 z1, z2;
#pragma unroll
                    for (int e = 0; e < 4; ++e) { float a1 = dpp_ror1(z[m][e]), a2 = dpp_ror2(z[m][e]);
                        if (m > 0) { const float xp = z[m > 0 ? m - 1 : 0][e]; const float p1 = dpp_ror1(xp), p2 = dpp_ror2(xp); a1 = fr >= 1 ? a1 : p1; a2 = fr >= 2 ? a2 : p2; }
                        if (t == 0) a1 = 0.f; if (t <= 1) a2 = 0.f; z1[e] = a1; z2[e] = a2; }
                    const f32x4 gb = acc[ai][0][m][0], ua = gb * (w0 * z2 + w1 * z1 + w2 * z[m]), ma = acc[ai][1][m][1] + bm;
                    bf16_t* rowp = O + (size_t)r * DP + xch;
                    if (m > 0 || fr >= 2) { u32x2 a; a.x = cvt_pk_bf16(ua[0], ua[1]); a.y = cvt_pk_bf16(ua[2], ua[3]); *(u32x2*)(rowp + C_UA) = a; }
                    { u32x2 g; g.x = cvt_pk_bf16(ma[0], ma[1]); g.y = cvt_pk_bf16(ma[2], ma[3]); *(u32x2*)(rowp + C_MA) = g; }
                    if (m == 0 && fr < 2) { const int blk = r >> 6; u32x2 a; a.x = cvt_pk_bf16(gb[0], gb[1]); a.y = cvt_pk_bf16(gb[2], gb[3]); *(u32x2*)(EFA + ((size_t)(blk * 2 + fr) * 2) * D + xch) = a;
                        u32x2 q; q.x = cvt_pk_bf16(z[0][0], z[0][1]); q.y = cvt_pk_bf16(z[0][2], z[0][3]); *(u32x2*)(EFA + ((size_t)(blk * 2 + fr) * 2 + 1) * D + xch) = q; }
                    if (m == 3 && fr >= 14) { const int blk = r >> 6; u32x2 q; q.x = cvt_pk_bf16(z[3][0], z[3][1]); q.y = cvt_pk_bf16(z[3][2], z[3][3]); *(u32x2*)(ELA + (size_t)(blk * 2 + (fr - 14)) * D + xch) = q; }
                    if (t >= TP - 2) *(f32x4*)(outp + ((size_t)(b * 2) + (t - (TP - 2))) * D + xch) = z[m]; }
            }
        }
    }
};

template <class Epi, bool ALIGN_EPI = true, bool SP2 = true>
__device__ __forceinline__ void gemm_phase(LAS unsigned char* lds, const Gemm g, const Order& S, const Epi& E) {
    const int tid = tid_(), wid = __builtin_amdgcn_readfirstlane(tid >> 6), lane = tid & 63, wr = wid >> 2, wc = wid & 3, fr = lane & 15, fq = lane >> 4;
    const int K = g.K, lda = g.lda;
    unsigned voffA[2], voffB[2];
#pragma unroll
    for (int i = 0; i < 2; ++i) { int R, C; stage_rc(tid * 16 + i * 8192, R, C); const int Rb = Epi::PERM ? ((R & ~31) + perm32(R & 31)) : R;
        voffA[i] = (unsigned)(R * lda + C) * 2u; voffB[i] = (unsigned)(Rb * K + C) * 2u; }
    const size_t kstep = (size_t)(BK * 2);
    const size_t hstepA = (size_t)HALF * lda * 2, hstepB = (size_t)HALF * K * 2;
    const size_t tstepA = 2 * hstepA, tstepB = 2 * hstepB;
    const unsigned ldsw = (unsigned)wid * 1024u;
    const int aoff = lds_byte(wr * 64 + fr, fq * 8), boff = lds_byte(wc * 32 + fr, fq * 8);
#define PG8_SA(b, h) (((b) * 2 + (h)) * HTB)
#define PG8_SB(b, h) ((4 + (b) * 2 + (h)) * HTB)
#define PG8_STAGE(bufoff, gbase, voff) do { _Pragma("unroll") for (int _i = 0; _i < 2; ++_i) \
        __builtin_amdgcn_global_load_lds((const unsigned*)((const char*)(gbase) + (voff)[_i]), (LAS unsigned*)(lds + (bufoff) + ldsw + _i * 8192), 16, 0, 0); } while (0)
#define PG8_LDA(dst, b, h) do { _Pragma("unroll") for (int m = 0; m < 4; ++m) _Pragma("unroll") for (int k = 0; k < 2; ++k) dst[m][k] = *(const LAS bf16x8*)(lds + PG8_SA(b, h) + aoff + m * 2048 + k * 1024); } while (0)
#define PG8_LDB(dst, b, h) do { _Pragma("unroll") for (int n = 0; n < 2; ++n) _Pragma("unroll") for (int k = 0; k < 2; ++k) dst[n][k] = *(const LAS bf16x8*)(lds + PG8_SB(b, h) + boff + n * 2048 + k * 1024); } while (0)
#define PG8_MMA(ai, bj, At, Bt) do { __builtin_amdgcn_s_setprio(1); _Pragma("unroll") for (int m = 0; m < 4; ++m) _Pragma("unroll") for (int n = 0; n < 2; ++n) _Pragma("unroll") for (int k = 0; k < 2; ++k) \
        acc[ai][bj][m][n] = __builtin_amdgcn_mfma_f32_16x16x32_bf16(Bt[n][k], At[m][k], acc[ai][bj][m][n], 0, 0, 0); __builtin_amdgcn_s_setprio(0); } while (0)
#define PG8_WAIT_V(n) asm volatile("s_waitcnt vmcnt(" #n ")" ::: "memory")
#define PG8_WAIT_L(n) asm volatile("s_waitcnt lgkmcnt(" #n ")" ::: "memory")
#define PG8_BAR __builtin_amdgcn_s_barrier()
#define PG8_SCHED __builtin_amdgcn_sched_barrier(0)
    Unit cur, nxt; int ui = 0;
    if (!S.next(0, cur)) return;
    f32x4 acc[2][2][4][2];
#pragma unroll
    for (int a = 0; a < 2; ++a)
#pragma unroll
        for (int b = 0; b < 2; ++b)
#pragma unroll
            for (int m = 0; m < 4; ++m)
#pragma unroll
                for (int n = 0; n < 2; ++n) acc[a][b][m][n] = (f32x4){0.f, 0.f, 0.f, 0.f};
    bf16x8 At[4][2], B0[2][2], B1[2][2];
    const char* cA = (const char*)(cur.z ? g.A1 : g.A0) + (size_t)cur.pm * tstepA + (size_t)cur.kt0 * kstep; const char* cB = (const char*)(cur.z ? g.B1 : g.B0) + (size_t)cur.pn * tstepB + (size_t)cur.kt0 * kstep;
    if constexpr (SP2) {
        PG8_STAGE(PG8_SB(0, 0), cB, voffB); PG8_STAGE(PG8_SB(0, 1), cB + hstepB, voffB); PG8_STAGE(PG8_SA(0, 0), cA, voffA); PG8_STAGE(PG8_SA(0, 1), cA + hstepA, voffA);
        if (wr == 1) PG8_BAR;
        PG8_WAIT_V(2); PG8_BAR;
        PG8_STAGE(PG8_SB(1, 0), cB + kstep, voffB); PG8_STAGE(PG8_SA(1, 0), cA + kstep, voffA); PG8_STAGE(PG8_SB(1, 1), cB + hstepB + kstep, voffB);
        PG8_WAIT_V(6); PG8_BAR;
    } else {
    PG8_STAGE(PG8_SB(0, 0), cB, voffB); PG8_STAGE(PG8_SA(0, 0), cA, voffA); PG8_STAGE(PG8_SB(0, 1), cB + hstepB, voffB); PG8_STAGE(PG8_SA(0, 1), cA + hstepA, voffA);
    if (wr == 1) PG8_BAR;
    PG8_WAIT_V(4); PG8_BAR;
    PG8_STAGE(PG8_SB(1, 0), cB + kstep, voffB); PG8_STAGE(PG8_SA(1, 0), cA + kstep, voffA); PG8_STAGE(PG8_SB(1, 1), cB + hstepB + kstep, voffB);
    PG8_WAIT_V(6); PG8_BAR;
    }
    for (;;) {
        const bool has_next = S.next(ui + 1, nxt);
        const char* nA = has_next ? (const char*)(nxt.z ? g.A1 : g.A0) + (size_t)nxt.pm * tstepA + (size_t)nxt.kt0 * kstep : cA; const char* nB = has_next ? (const char*)(nxt.z ? g.B1 : g.B0) + (size_t)nxt.pn * tstepB + (size_t)nxt.kt0 * kstep : cB;
        const int nt = cur.nkt;
        for (int t = 0; t < nt; t += 2) {
            const bool last = (t == nt - 2);
            const char* a1 = cA + (size_t)(t + 1) * kstep;
            const char* a2 = last ? nA : cA + (size_t)(t + 2) * kstep; const char* b2 = last ? nB : cB + (size_t)(t + 2) * kstep;
            const char* a3 = a2 + kstep; const char* b3 = b2 + kstep;
            if constexpr (SP2) {
            PG8_LDB(B0, 0, 0); PG8_LDB(B1, 0, 1); PG8_SCHED; PG8_LDA(At, 0, 0); PG8_STAGE(PG8_SA(1, 1), a1 + hstepA, voffA);
            PG8_WAIT_V(8); PG8_WAIT_L(0); PG8_BAR; PG8_MMA(0, 0, At, B0); PG8_MMA(0, 1, At, B1); PG8_BAR; PG8_SCHED;
            PG8_LDA(At, 0, 1); PG8_STAGE(PG8_SB(0, 0), b2, voffB); PG8_STAGE(PG8_SB(0, 1), b2 + hstepB, voffB); PG8_STAGE(PG8_SA(0, 0), a2, voffA);
            PG8_WAIT_V(8); PG8_WAIT_L(0); PG8_BAR; PG8_MMA(1, 0, At, B0); PG8_MMA(1, 1, At, B1); PG8_BAR; PG8_SCHED;
            PG8_LDB(B0, 1, 0); PG8_LDB(B1, 1, 1); PG8_SCHED; PG8_LDA(At, 1, 0); PG8_STAGE(PG8_SA(0, 1), a2 + hstepA, voffA);
            PG8_WAIT_V(8); PG8_WAIT_L(0); PG8_BAR; PG8_MMA(0, 0, At, B0); PG8_MMA(0, 1, At, B1); PG8_BAR; PG8_SCHED;
            PG8_LDA(At, 1, 1); PG8_STAGE(PG8_SB(1, 0), b3, voffB); PG8_STAGE(PG8_SB(1, 1), b3 + hstepB, voffB); PG8_STAGE(PG8_SA(1, 0), a3, voffA);
            PG8_WAIT_V(8); PG8_WAIT_L(0); PG8_BAR; PG8_MMA(1, 0, At, B0); PG8_MMA(1, 1, At, B1); PG8_BAR; PG8_SCHED;
            } else {
            PG8_LDB(B0, 0, 0); PG8_SCHED; PG8_LDA(At, 0, 0); PG8_STAGE(PG8_SA(1, 1), a1 + hstepA, voffA);
            PG8_WAIT_L(8); PG8_BAR; PG8_WAIT_L(0); PG8_MMA(0, 0, At, B0); PG8_BAR; PG8_SCHED;
            PG8_LDB(B1, 0, 1); PG8_STAGE(PG8_SB(0, 0), b2, voffB);
            PG8_BAR; PG8_WAIT_L(0); PG8_MMA(0, 1, At, B1); PG8_BAR;
            PG8_LDA(At, 0, 1); PG8_STAGE(PG8_SA(0, 0), a2, voffA);
            PG8_BAR; PG8_WAIT_L(0); PG8_MMA(1, 0, At, B0); PG8_BAR; PG8_SCHED;
            PG8_STAGE(PG8_SB(0, 1), b2 + hstepB, voffB);
            PG8_WAIT_V(6); PG8_BAR; PG8_MMA(1, 1, At, B1); PG8_BAR;
            PG8_LDB(B0, 1, 0); PG8_SCHED; PG8_LDA(At, 1, 0); PG8_STAGE(PG8_SA(0, 1), a2 + hstepA, voffA);
            PG8_WAIT_L(8); PG8_BAR; PG8_WAIT_L(0); PG8_MMA(0, 0, At, B0); PG8_BAR; PG8_SCHED;
            PG8_LDB(B1, 1, 1); PG8_STAGE(PG8_SB(1, 0), b3, voffB);
            PG8_BAR; PG8_WAIT_L(0); PG8_MMA(0, 1, At, B1); PG8_BAR;
            PG8_LDA(At, 1, 1); PG8_STAGE(PG8_SA(1, 0), a3, voffA);
            PG8_BAR; PG8_WAIT_L(0); PG8_MMA(1, 0, At, B0); PG8_BAR; PG8_SCHED;
            PG8_STAGE(PG8_SB(1, 1), b3 + hstepB, voffB);
            PG8_WAIT_V(6); PG8_BAR; PG8_MMA(1, 1, At, B1); PG8_BAR;
            }
        }
        if constexpr (ALIGN_EPI) { if (wr == 0) PG8_BAR; }
        bool chained = false;
        if constexpr (Epi::CHAIN) { if (cur.z == 0 && cur.kt0 == 0 && cur.nkt * BK == K) { E.mid(acc, cur, wr, wc, fr, fq); chained = true; } }
        if (!chained) E(acc, cur, wr, wc, fr, fq);
        if (!has_next) break;
        if (!chained) {
#pragma unroll
        for (int a = 0; a < 2; ++a)
#pragma unroll
            for (int b = 0; b < 2; ++b)
#pragma unroll
                for (int m = 0; m < 4; ++m)
#pragma unroll
                    for (int n = 0; n < 2; ++n) acc[a][b][m][n] = (f32x4){0.f, 0.f, 0.f, 0.f};
        }
        cur = nxt; cA = nA; cB = nB; ++ui;
        if constexpr (ALIGN_EPI) { if (wr == 1) PG8_BAR; }
    }
    PG8_WAIT_V(0);
    if constexpr (!ALIGN_EPI) { if (wr == 0) PG8_BAR; }
    PG8_BAR;
#undef PG8_SA
#undef PG8_SB
#undef PG8_STAGE
#undef PG8_LDA
#undef PG8_LDB
#undef PG8_MMA
#undef PG8_WAIT_V
#undef PG8_WAIT_L
#undef PG8_BAR
#undef PG8_SCHED
}
}

__device__ __forceinline__ int winrow(int n) {
    const int st = n >> 10, ch = n & 1023;
    if (st == 3) return 4096 + ch; if (st == 4) return 5120 + ch; if (st == 6) return 6144 + ch;
    const int s = st == 5 ? 3 : st, j = ch >> 6, w = ch & 63;
    return 256 * j + 128 * (s >> 1) + 32 * (w >> 4) + 8 * ((w & 15) >> 2) + 4 * (s & 1) + (w & 3);
}
__device__ __forceinline__ void transpose_item(const float* W, int K, int N, bf16_t* WT, const float* scale, int item, int lane, int mode) {
    const int nblk = N >> 6, kb = item / nblk, nb = item - kb * nblk, n = 64 * nb + lane, k0 = 64 * kb;
    const int nr = mode == -2 ? winrow(n) : mode < 0 ? n : ((n >> 7) * 256 + (n & 127) + mode);
    const float* src = W + (size_t)k0 * N + n; bf16_t* dst = WT + (size_t)nr * K + k0;
    float v[64];
#pragma unroll
    for (int i = 0; i < 64; ++i) v[i] = __builtin_nontemporal_load(src + (size_t)i * N);
    if (scale) {
#pragma unroll
        for (int i = 0; i < 64; ++i) v[i] *= scale[k0 + i]; }
#pragma unroll
    for (int j = 0; j < 8; ++j) { u32x4 o; o.x = cvt_pk_bf16(v[8 * j], v[8 * j + 1]); o.y = cvt_pk_bf16(v[8 * j + 2], v[8 * j + 3]); o.z = cvt_pk_bf16(v[8 * j + 4], v[8 * j + 5]); o.w = cvt_pk_bf16(v[8 * j + 6], v[8 * j + 7]);
        *(u32x4*)(dst + 8 * j) = o; }
}

__device__ __forceinline__ void convert_phase(KP p, int l, int part, int vcu, int nvcu) {
    const int tid = tid_(), lane = tid & 63, wave = __builtin_amdgcn_readfirstlane(tid >> 6);
    const int gw = vcu * 8 + wave, NGW = nvcu * 8;
    unsigned char* ws = p->ws;
    constexpr int I_IN = 16 * 112, I_SQ = 16 * 16, I_UP = 16 * 44, I_DN = 44 * 16, I_RG = 16;
    constexpr int NIT = I_IN + 3 * I_SQ + 2 * I_UP + I_DN + 2 * I_RG;
    const int lo = part == 0 ? 0 : I_IN, hi = part == 0 ? I_IN : NIT;
    for (int it = lo + gw; it < hi; it += NGW) {
        int r = it;
        if (r < I_IN) { transpose_item(p->in[10] + (size_t)l * D * DIN, D, DIN, (bf16_t*)(ws + WS_WIN), p->in[7] + l * D, r, lane, -2); continue; } r -= I_IN;
        if (r < I_SQ) { transpose_item(p->in[13] + (size_t)l * D * D, D, D, (bf16_t*)(ws + WS_WA), nullptr, r, lane, -1); continue; } r -= I_SQ;
        if (r < I_SQ) { transpose_item(p->in[21] + (size_t)l * D * D, D, D, (bf16_t*)(ws + WS_WB), nullptr, r, lane, -1); continue; } r -= I_SQ;
        if (r < I_SQ) { transpose_item(p->in[22] + (size_t)l * D * D, D, D, (bf16_t*)(ws + WS_WO), nullptr, r, lane, -1); continue; } r -= I_SQ;
        if (r < I_UP) { transpose_item(p->in[23] + (size_t)l * D * DFF, D, DFF, (bf16_t*)(ws + WS_WUG), p->in[8] + l * D, r, lane, 0); continue; } r -= I_UP;
        if (r < I_UP) { transpose_item(p->in[24] + (size_t)l * D * DFF, D, DFF, (bf16_t*)(ws + WS_WUG), p->in[8] + l * D, r, lane, 128); continue; } r -= I_UP;
        if (r < I_DN) { transpose_item(p->in[27] + (size_t)l * DFF * D, DFF, D, (bf16_t*)(ws + WS_WD), nullptr, r, lane, -1); continue; } r -= I_DN;
        if (r < I_RG) { transpose_item(p->in[16] + (size_t)l * 16 * 4096 + r * 4096, 64, 64, (bf16_t*)(ws + WS_RGA) + r * 4096, nullptr, 0, lane, -1); continue; } r -= I_RG;
        transpose_item(p->in[18] + (size_t)l * 16 * 4096 + r * 4096, 64, 64, (bf16_t*)(ws + WS_RGX) + r * 4096, nullptr, 0, lane, -1);
    }
    const int gt = part == 0 ? vcu * 512 + tid : DIN;
    if (gt < DIN) { float bv = 0.f;
        if (gt < 4096) { const int rem = gt & 255, sidx = 2 * (rem >> 7) + ((rem & 7) >> 2), ch = 64 * (gt >> 8) + 16 * ((rem & 127) >> 5) + 4 * ((rem & 31) >> 3) + (rem & 3); if (sidx == 3) bv = p->in[11][l * 2048 + ch]; }
        else if (gt >= 6144) bv = p->in[11][l * 2048 + 1024 + gt - 6144];
        ((float*)(ws + WS_BIASP))[gt] = bv; }
    if (gt < D) { const float x = -p->in[20][l * D + gt]; ((float*)(ws + WS_SP))[gt] = fmaxf(x, 0.f) + log1pf(expf(-fabsf(x))); }
}

__device__ __forceinline__ const float* src_row(KP p, int m) {
    if (m >= MP) return p->in[1] + (size_t)(m - MP) * D;
    const int b = m / TP, t = m - b * TP;
    return t < NMETA ? p->in[6] + (size_t)t * D : p->in[0] + ((size_t)b * SEQ + (t - NMETA)) * D;
}
__device__ __forceinline__ void norm_phase(KP p, bool first, int nslab) {
    const int tid = tid_(), lane = tid & 63, wave = __builtin_amdgcn_readfirstlane(tid >> 6);
    const int gw = bid_() * 8 + wave, NGW = gdim_() * 8;
    bf16_t* X = (bf16_t*)(p->ws + WS_X); bf16_t* XN = (bf16_t*)(p->ws + WS_R2);
    for (int m = gw; m < M; m += NGW) {
        f32x4 v[4]; float s = 0.f;
        if (first) { const f32x4* xr = (const f32x4*)src_row(p, m) + lane;
#pragma unroll
            for (int j = 0; j < 4; ++j) v[j] = __builtin_nontemporal_load(xr + 64 * j); }
        else { const u32x2* xr = (const u32x2*)(X + (size_t)m * D) + lane;
#pragma unroll
            for (int j = 0; j < 4; ++j) { const u32x2 w = xr[64 * j]; v[j] = (f32x4){bflo(w.x), bfhi(w.x), bflo(w.y), bfhi(w.y)}; } }
        const bool fold = (!first) && m >= 64 * 256;
        if (fold) { const f32x4* sl = (const f32x4*)(p->ws + WS_SLAB) + (size_t)(m - 64 * 256) * (D / 4) + lane;
            for (int q = 0; q < nslab; ++q) {
#pragma unroll
                for (int j = 0; j < 4; ++j) v[j] += sl[(size_t)q * 256 * (D / 4) + 64 * j]; } }
        if (first || fold) { u32x2* xo = (u32x2*)(X + (size_t)m * D) + lane;
#pragma unroll
            for (int j = 0; j < 4; ++j) { u32x2 w; w.x = cvt_pk_bf16(v[j][0], v[j][1]); w.y = cvt_pk_bf16(v[j][2], v[j][3]); xo[64 * j] = w; } }
#pragma unroll
        for (int j = 0; j < 4; ++j) s += (v[j][0] * v[j][0] + v[j][1] * v[j][1]) + (v[j][2] * v[j][2] + v[j][3] * v[j][3]);
        const float rinv = rsqrtf(wave_sum(s) * (1.f / D) + EPS);
        u32x2* o8 = (u32x2*)(XN + (size_t)m * D) + lane;
#pragma unroll
        for (int j = 0; j < 4; ++j) { u32x2 w; w.x = cvt_pk_bf16(v[j][0] * rinv, v[j][1] * rinv); w.y = cvt_pk_bf16(v[j][2] * rinv, v[j][3] * rinv); o8[64 * j] = w; }
    }
}
__device__ __forceinline__ void final_norm_phase(KP p) {
    const int tid = tid_(), lane = tid & 63, wave = __builtin_amdgcn_readfirstlane(tid >> 6);
    const int gw = bid_() * 8 + wave, NGW = gdim_() * 8;
    const bf16_t* X = (const bf16_t*)(p->ws + WS_X); const f32x4* gp = (const f32x4*)p->in[9] + lane;
    for (int m = gw; m < M; m += NGW) {
        float* dst;
        if (m >= MP) dst = p->out + O_YS + (size_t)(m - MP) * D;
        else { const int b = m / TP, t = m - b * TP; if (t < NMETA) continue; dst = p->out + O_YP + ((size_t)b * SEQ + (t - NMETA)) * D; }
        const u32x2* xr = (const u32x2*)(X + (size_t)m * D) + lane;
        f32x4 v[4]; float s = 0.f;
#pragma unroll
        for (int j = 0; j < 4; ++j) { const u32x2 w = xr[64 * j]; v[j] = (f32x4){bflo(w.x), bfhi(w.x), bflo(w.y), bfhi(w.y)}; }
        if (m >= 64 * 256) { const f32x4* sl = (const f32x4*)(p->ws + WS_SLAB) + (size_t)(m - 64 * 256) * (D / 4) + lane;
            for (int q = 0; q < 11; ++q) {
#pragma unroll
                for (int j = 0; j < 4; ++j) v[j] += sl[(size_t)q * 256 * (D / 4) + 64 * j]; } }
#pragma unroll
        for (int j = 0; j < 4; ++j) s += (v[j][0] * v[j][0] + v[j][1] * v[j][1]) + (v[j][2] * v[j][2] + v[j][3] * v[j][3]);
        const float rinv = rsqrtf(wave_sum(s) * (1.f / D) + EPS);
        f32x4* o = (f32x4*)dst + lane;
#pragma unroll
        for (int j = 0; j < 4; ++j) __builtin_nontemporal_store(v[j] * rinv * gp[64 * j], o + 64 * j);
    }
}

__device__ __forceinline__ void mixed_fold_phase(KP p) {
    const int tid = tid_(), lane = tid & 63, wave = __builtin_amdgcn_readfirstlane(tid >> 6);
    const int gw = bid_() * 8 + wave, NGW = gdim_() * 8;
    bf16_t* P = (bf16_t*)(p->ws + WS_BIG);
    for (int r = gw; r < 256; r += NGW) {
        const f32x4* sl = (const f32x4*)(p->ws + WS_SLAB) + (size_t)r * (D / 4) + lane;
        f32x4 v[4];
#pragma unroll
        for (int j = 0; j < 4; ++j) v[j] = sl[64 * j];
        for (int q = 1; q < 8; ++q) {
#pragma unroll
            for (int j = 0; j < 4; ++j) v[j] += sl[(size_t)q * 256 * (D / 4) + 64 * j]; }
        u32x2* o8 = (u32x2*)(P + (size_t)(64 * 256 + r) * DP + C_MIX) + lane;
#pragma unroll
        for (int j = 0; j < 4; ++j) { u32x2 w; w.x = cvt_pk_bf16(v[j][0], v[j][1]); w.y = cvt_pk_bf16(v[j][2], v[j][3]); o8[64 * j] = w; }
    }
}

__device__ __forceinline__ void mixa_edge_phase(KP p, int l) {
    bf16_t* P = (bf16_t*)(p->ws + WS_BIG); const bf16_t* EFA = (const bf16_t*)(p->ws + WS_SLAB); const bf16_t* ELA = EFA + (size_t)260 * 2 * 2 * D;
    const int gt = bid_() * 512 + tid_(), NT = gdim_() * 512;
    const float* cw = p->in[12] + (size_t)l * 3 * D;
    for (int it = gt; it < 258 * 2 * 128; it += NT) {
        const int rq = it >> 7, c0 = (it & 127) * 8, q = rq & 1, blk = rq >> 1, r = 64 * blk + q, b = r / TP, t = r - b * TP;
        float w0[8], w1[8], w2[8]; load8f(cw + c0, w0); load8f(cw + D + c0, w1); load8f(cw + 2 * D + c0, w2);
        float gb[8], z0[8], z1[8], z2[8], o[8];
        unpack8(*(const u32x4*)(EFA + ((size_t)(blk * 2 + q) * 2) * D + c0), gb); unpack8(*(const u32x4*)(EFA + ((size_t)(blk * 2 + q) * 2 + 1) * D + c0), z0);
#pragma unroll
        for (int e = 0; e < 8; ++e) { z1[e] = 0.f; z2[e] = 0.f; }
        if (t >= 1) { if (q == 1) unpack8(*(const u32x4*)(EFA + ((size_t)(blk * 2) * 2 + 1) * D + c0), z1); else unpack8(*(const u32x4*)(ELA + (size_t)((blk - 1) * 2 + 1) * D + c0), z1); }
        if (t >= 2) { if (q == 1) unpack8(*(const u32x4*)(ELA + (size_t)((blk - 1) * 2 + 1) * D + c0), z2); else unpack8(*(const u32x4*)(ELA + (size_t)((blk - 1) * 2) * D + c0), z2); }
#pragma unroll
        for (int e = 0; e < 8; ++e) o[e] = gb[e] * (w0[e] * z2[e] + w1[e] * z1[e] + w2[e] * z0[e]);
        *(u32x4*)(P + (size_t)r * DP + C_UA + c0) = pack8(o);
    }
}

template <int NT>
__device__ __forceinline__ void scan_tiles(KP p, int l, const bf16_t* P, bf16_t* HLOC, bf16_t* PCUM, LAS float* XCb, LAS const float* CST, const bf16x8 (&Wa)[4][2], const bf16x8 (&Wx)[4][2],
                                           int b, int hc0, int m0, int lane, int fr, int fq, float (&Hc)[4], float (&Pc)[4]) {
    const int rr = lane >> 2, cl = (lane & 3) * 16;
    u32x4 raw[NT][4][2];
#pragma unroll
    for (int u = 0; u < NT; ++u) { const int m = m0 + 16 * u + rr, t = m - b * TP;
#pragma unroll
        for (int k = 0; k < 4; ++k) {
            if (t - 3 + k >= 0) { const bf16_t* src = P + (size_t)(m - 3 + k) * DP + C_XR + hc0 + cl; raw[u][k][0] = *(const u32x4*)src; raw[u][k][1] = *(const u32x4*)(src + 8); }
            else { raw[u][k][0] = (u32x4){0u, 0u, 0u, 0u}; raw[u][k][1] = (u32x4){0u, 0u, 0u, 0u}; } } }
    LDS_WAIT();
#pragma unroll
    for (int u = 0; u < NT; ++u) { const int m = m0 + 16 * u + rr, t = m - b * TP; LAS float* XC = XCb + u * (16 * 68);
        float xv[4][16];
#pragma unroll
        for (int k = 0; k < 4; ++k) { float f0[8], f1[8]; unpack8(raw[u][k][0], f0); unpack8(raw[u][k][1], f1);
#pragma unroll
            for (int e = 0; e < 8; ++e) { xv[k][e] = f0[e]; xv[k][8 + e] = f1[e]; } }
        if (t >= TP - 3) { float* o = p->out + O_PCB + ((size_t)(l * NB + b) * 3 + (t - (TP - 3))) * D + hc0 + cl;
#pragma unroll
            for (int e = 0; e < 16; e += 4) *(f32x4*)(o + e) = (f32x4){xv[3][e], xv[3][e + 1], xv[3][e + 2], xv[3][e + 3]}; }
#pragma unroll
        for (int e = 0; e < 16; e += 4) {
            const f32x4 w0 = *(const LAS f32x4*)(CST + 0 * 64 + cl + e), w1 = *(const LAS f32x4*)(CST + 1 * 64 + cl + e), w2 = *(const LAS f32x4*)(CST + 2 * 64 + cl + e),
                        w3 = *(const LAS f32x4*)(CST + 3 * 64 + cl + e), bb = *(const LAS f32x4*)(CST + 4 * 64 + cl + e);
            f32x4 r;
#pragma unroll
            for (int q = 0; q < 4; ++q) r[q] = w0[q] * xv[0][e + q] + w1[q] * xv[1][e + q] + w2[q] * xv[2][e + q] + w3[q] * xv[3][e + q] + bb[q];
            *(LAS f32x4*)(XC + rr * 68 + cl + e) = r;
        } }
    LDS_WAIT();
    f32x4 ar[NT][4], ai[NT][4];
#pragma unroll
    for (int u = 0; u < NT; ++u) { const LAS float* XC = XCb + u * (16 * 68);
#pragma unroll
        for (int n = 0; n < 4; ++n) { ar[u][n] = (f32x4){0.f, 0.f, 0.f, 0.f}; ai[u][n] = (f32x4){0.f, 0.f, 0.f, 0.f}; }
#pragma unroll
        for (int s = 0; s < 2; ++s) {
            const f32x4 x0 = *(const LAS f32x4*)(XC + fr * 68 + 32 * s + 8 * fq), x1 = *(const LAS f32x4*)(XC + fr * 68 + 32 * s + 8 * fq + 4);
            u32x4 aw; aw.x = cvt_pk_bf16(x0[0], x0[1]); aw.y = cvt_pk_bf16(x0[2], x0[3]); aw.z = cvt_pk_bf16(x1[0], x1[1]); aw.w = cvt_pk_bf16(x1[2], x1[3]);
            const bf16x8 af = __builtin_bit_cast(bf16x8, aw);
#pragma unroll
            for (int n = 0; n < 4; ++n) { ar[u][n] = __builtin_amdgcn_mfma_f32_16x16x32_bf16(af, Wa[n][s], ar[u][n], 0, 0, 0); ai[u][n] = __builtin_amdgcn_mfma_f32_16x16x32_bf16(af, Wx[n][s], ai[u][n], 0, 0, 0); }
        } }
    float av[NT][4][4], bv[NT][4][4];
#pragma unroll
    for (int u = 0; u < NT; ++u) { const LAS float* XC = XCb + u * (16 * 68); const int t0 = m0 + 16 * u - b * TP;
#pragma unroll
        for (int n = 0; n < 4; ++n) { const int cc = 16 * n + fr;
            const float ba = CST[5 * 64 + cc], bx = CST[6 * 64 + cc], sp = CST[7 * 64 + cc];
#pragma unroll
            for (int j = 0; j < 4; ++j) {
                const float xc = XC[(4 * fq + j) * 68 + cc];
                const float r = sigmoidf_(ar[u][n][j] + ba), ig = sigmoidf_(ai[u][n][j] + bx);
                const float a = __expf(-8.0f * r * sp);
                float mult = sqrtf(fmaxf(1.0f - a * a, 0.f));
                if (t0 + 4 * fq + j == 0) mult = 1.0f;
                av[u][n][j] = a; bv[u][n][j] = mult * ig * xc; } } }
#pragma unroll
    for (int u = 0; u < NT; ++u) {
#pragma unroll
        for (int n = 0; n < 4; ++n) { const int ch = hc0 + 16 * n + fr;
            float hl[4], pl[4];
            hl[0] = bv[u][n][0]; pl[0] = av[u][n][0];
#pragma unroll
            for (int j = 1; j < 4; ++j) { hl[j] = av[u][n][j] * hl[j - 1] + bv[u][n][j]; pl[j] = av[u][n][j] * pl[j - 1]; }
            float He = 0.f, Pe = 1.f;
#pragma unroll
            for (int g = 0; g < 3; ++g) { const float Pg = __shfl(pl[3], fr + 16 * g), Hg = __shfl(hl[3], fr + 16 * g); if (g < fq) { He = Pg * He + Hg; Pe = Pg * Pe; } }
            const float Hin = Pe * Hc[n] + He, Pin = Pe * Pc[n];
            float hf[4], pf[4];
#pragma unroll
            for (int j = 0; j < 4; ++j) { hf[j] = hl[j] + pl[j] * Hin; pf[j] = pl[j] * Pin; }
#pragma unroll
            for (int j = 0; j < 4; ++j) { const size_t o = (size_t)(m0 + 16 * u + 4 * fq + j) * D + ch; HLOC[o] = (bf16_t)(cvt_pk_bf16(hf[j], 0.f) & 0xffffu); PCUM[o] = (bf16_t)(cvt_pk_bf16(pf[j], 0.f) & 0xffffu); }
            Hc[n] = __shfl(hf[3], fr + 48); Pc[n] = __shfl(pf[3], fr + 48);
        } }
}

__device__ __forceinline__ void scan_phase(KP p, int l, LAS unsigned char* lds) {
    const int tid = tid_(), lane = tid & 63, wave = __builtin_amdgcn_readfirstlane(tid >> 6), fr = lane & 15, fq = lane >> 4;
    const int gw = bid_() * 8 + wave, NGW = gdim_() * 8;
    LAS float* XC = (LAS float*)(lds + wave * 16384);
    LAS float* CST = XC + 2 * 16 * 68;
    const bf16_t* P = (const bf16_t*)(p->ws + WS_BIG);
    bf16_t* HLOC = (bf16_t*)(p->ws + WS_R2); bf16_t* PCUM = (bf16_t*)(p->ws + WS_R2 + R2_PCUM);
    float* SUMM = (float*)(p->ws + WS_SUMM);
    const float* SP = (const float*)(p->ws + WS_SP);
    constexpr int NTASK = (128 + 8) * 16;
    for (int task = gw; task < NTASK; task += NGW) {
        const int head = task & 15, ck = task >> 4, hc0 = head * 64;
        LDS_WAIT();
        {
            const int ch = hc0 + lane;
#pragma unroll
            for (int k = 0; k < 4; ++k) CST[k * 64 + lane] = p->in[14][(size_t)(l * 4 + k) * D + ch];
            CST[4 * 64 + lane] = p->in[15][l * D + ch]; CST[5 * 64 + lane] = p->in[17][l * D + ch]; CST[6 * 64 + lane] = p->in[19][l * D + ch]; CST[7 * 64 + lane] = SP[ch];
        }
        bf16x8 Wa[4][2], Wx[4][2];
#pragma unroll
        for (int n = 0; n < 4; ++n)
#pragma unroll
            for (int s = 0; s < 2; ++s) { const size_t o = (size_t)head * 4096 + (16 * n + fr) * 64 + 32 * s + 8 * fq;
                Wa[n][s] = *(const bf16x8*)((const bf16_t*)(p->ws + WS_RGA) + o); Wx[n][s] = *(const bf16x8*)((const bf16_t*)(p->ws + WS_RGX) + o); }
        if (ck < 128) {
            const int b = ck >> 4, q = ck & 15, tile0 = b * 129 + 8 * q;
            float Hc[4], Pc[4];
#pragma unroll
            for (int n = 0; n < 4; ++n) { Hc[n] = 0.f; Pc[n] = 1.f; }
            for (int tt = 0; tt < 8; tt += 2) scan_tiles<2>(p, l, P, HLOC, PCUM, XC, CST, Wa, Wx, b, hc0, (tile0 + tt) * 16, lane, fr, fq, Hc, Pc);
            if (q == 15) scan_tiles<1>(p, l, P, HLOC, PCUM, XC, CST, Wa, Wx, b, hc0, (tile0 + 8) * 16, lane, fr, fq, Hc, Pc);
            if (fq == 0) {
#pragma unroll
                for (int n = 0; n < 4; ++n) { const int ch = hc0 + 16 * n + fr; SUMM[(size_t)ck * 2 * D + ch] = Pc[n]; SUMM[(size_t)ck * 2 * D + D + ch] = Hc[n]; } }
        } else {
            const int m0 = (1032 + (ck - 128)) * 16;
            LDS_WAIT();
            {   const int rr = lane >> 2, cb = lane & 3, cl = cb * 16, m = m0 + rr, sb = m - MP;
                float xv[4][16];
                const float* st = p->in[3] + ((size_t)(l * MS + sb) * 3) * D + hc0 + cl;
#pragma unroll
                for (int k = 0; k < 3; ++k)
#pragma unroll
                    for (int e = 0; e < 16; e += 4) { const f32x4 v = *(const f32x4*)(st + (size_t)k * D + e); xv[k][e] = v[0]; xv[k][e + 1] = v[1]; xv[k][e + 2] = v[2]; xv[k][e + 3] = v[3]; }
                const bf16_t* src = P + (size_t)m * DP + C_XR + hc0 + cl;
                float f0[8], f1[8]; unpack8(*(const u32x4*)src, f0); unpack8(*(const u32x4*)(src + 8), f1);
#pragma unroll
                for (int e = 0; e < 8; ++e) { xv[3][e] = f0[e]; xv[3][8 + e] = f1[e]; }
                float* o = p->out + O_SCB + ((size_t)(l * MS + sb) * 3) * D + hc0 + cl;
#pragma unroll
                for (int k = 0; k < 3; ++k)
#pragma unroll
                    for (int e = 0; e < 16; e += 4) *(f32x4*)(o + (size_t)k * D + e) = (f32x4){xv[k + 1][e], xv[k + 1][e + 1], xv[k + 1][e + 2], xv[k + 1][e + 3]};
#pragma unroll
                for (int e = 0; e < 16; e += 4) {
                    const f32x4 w0 = *(const LAS f32x4*)(CST + 0 * 64 + cl + e), w1 = *(const LAS f32x4*)(CST + 1 * 64 + cl + e), w2 = *(const LAS f32x4*)(CST + 2 * 64 + cl + e),
                                w3 = *(const LAS f32x4*)(CST + 3 * 64 + cl + e), bb = *(const LAS f32x4*)(CST + 4 * 64 + cl + e);
                    f32x4 r;
#pragma unroll
                    for (int q = 0; q < 4; ++q) r[q] = w0[q] * xv[0][e + q] + w1[q] * xv[1][e + q] + w2[q] * xv[2][e + q] + w3[q] * xv[3][e + q] + bb[q];
                    *(LAS f32x4*)(XC + rr * 68 + cl + e) = r;
                }
            }
            LDS_WAIT();
            f32x4 ar[4], ai[4];
#pragma unroll
            for (int n = 0; n < 4; ++n) { ar[n] = (f32x4){0.f, 0.f, 0.f, 0.f}; ai[n] = (f32x4){0.f, 0.f, 0.f, 0.f}; }
#pragma unroll
            for (int s = 0; s < 2; ++s) {
                const f32x4 x0 = *(const LAS f32x4*)(XC + fr * 68 + 32 * s + 8 * fq), x1 = *(const LAS f32x4*)(XC + fr * 68 + 32 * s + 8 * fq + 4);
                u32x4 aw; aw.x = cvt_pk_bf16(x0[0], x0[1]); aw.y = cvt_pk_bf16(x0[2], x0[3]); aw.z = cvt_pk_bf16(x1[0], x1[1]); aw.w = cvt_pk_bf16(x1[2], x1[3]);
                const bf16x8 af = __builtin_bit_cast(bf16x8, aw);
#pragma unroll
                for (int n = 0; n < 4; ++n) { ar[n] = __builtin_amdgcn_mfma_f32_16x16x32_bf16(af, Wa[n][s], ar[n], 0, 0, 0); ai[n] = __builtin_amdgcn_mfma_f32_16x16x32_bf16(af, Wx[n][s], ai[n], 0, 0, 0); }
            }
#pragma unroll
            for (int n = 0; n < 4; ++n) {
                const int cc = 16 * n + fr, ch = hc0 + cc;
                const float ba = CST[5 * 64 + cc], bx = CST[6 * 64 + cc], sp = CST[7 * 64 + cc];
#pragma unroll
                for (int j = 0; j < 4; ++j) {
                    const float xc = XC[(4 * fq + j) * 68 + cc];
                    const float r = sigmoidf_(ar[n][j] + ba), ig = sigmoidf_(ai[n][j] + bx);
                    const float a = __expf(-8.0f * r * sp);
                    const float mult = sqrtf(fmaxf(1.0f - a * a, 0.f));
                    const int sb = m0 - MP + 4 * fq + j;
                    const float h0 = p->in[4][(size_t)(l * MS + sb) * D + ch];
                    const float h = a * h0 + mult * ig * xc;
                    const size_t o = (size_t)(m0 + 4 * fq + j) * D + ch; HLOC[o] = (bf16_t)(cvt_pk_bf16(h, 0.f) & 0xffffu); PCUM[o] = 0;
                    p->out[O_SRG + (size_t)(l * MS + sb) * D + ch] = h; }
            }
        }
    }
}

__device__ __forceinline__ void fixup_phase(KP p, int l) {
    bf16_t* P = (bf16_t*)(p->ws + WS_BIG);
    const bf16_t* HLOC = (const bf16_t*)(p->ws + WS_R2); const bf16_t* PCUM = (const bf16_t*)(p->ws + WS_R2 + R2_PCUM);
    const float* SUMM = (const float*)(p->ws + WS_SUMM);
    const int gt = bid_() * 512 + tid_(), NT = gdim_() * 512;
    for (int it = gt; it < (M / 16) * 128; it += NT) {
        const int tile = it >> 7, c0 = (it & 127) * 8, m0 = tile * 16;
        float carry[8];
#pragma unroll
        for (int e = 0; e < 8; ++e) carry[e] = 0.f;
        int b = 0, t0 = 1;
        if (tile < 1032) {
            b = tile / 129; const int tb = tile - b * 129; int q = tb >> 3; if (q > 15) q = 15; t0 = tb * 16;
            for (int qq = 0; qq < q; ++qq) { float Pq[8], Hq[8]; const float* s = SUMM + (size_t)(b * 16 + qq) * 2 * D + c0; load8f(s, Pq); load8f(s + D, Hq);
#pragma unroll
                for (int e = 0; e < 8; ++e) carry[e] = Pq[e] * carry[e] + Hq[e]; }
        }
#pragma unroll 4
        for (int i = 0; i < 16; ++i) {
            const size_t m = (size_t)(m0 + i);
            float hl[8], pc[8], gr[8], o[8], h[8];
            unpack8(__builtin_nontemporal_load((const u32x4*)(HLOC + m * D + c0)), hl); unpack8(__builtin_nontemporal_load((const u32x4*)(PCUM + m * D + c0)), pc);
            bf16_t* gp = P + m * DP + C_GR + c0; unpack8(*(const u32x4*)gp, gr);
#pragma unroll
            for (int e = 0; e < 8; ++e) { h[e] = hl[e] + pc[e] * carry[e]; o[e] = gelu_tanh(gr[e]) * h[e]; }
            *(u32x4*)gp = pack8(o);
            if (tile < 1032 && t0 + i == TP - 1) store8f(p->out + O_PRG + (size_t)(l * NB + b) * D + c0, h);
        }
    }
}

__device__ __forceinline__ void ffn_edge_phase(KP p, int l) {
    bf16_t* ACT = (bf16_t*)(p->ws + WS_BIG); const bf16_t* EF = (const bf16_t*)(p->ws + WS_SLAB); const bf16_t* EL = EF + (size_t)260 * 2 * 2 * DFF;
    const int gt = bid_() * 512 + tid_(), NT = gdim_() * 512;
    constexpr int NCG = DFF / 8, NIT = 258 * 2 * NCG;
    const float* cw = p->in[25] + (size_t)l * 3 * DFF; const float* cb = p->in[26] + (size_t)l * DFF;
    for (int it = gt; it < NIT; it += NT) {
        const int rq = it / NCG, c0 = (it - rq * NCG) * 8, q = rq & 1, blk = rq >> 1, r = 64 * blk + q, b = r / TP, t = r - b * TP;
        float w0[8], w1[8], w2[8], bb[8]; load8f(cw + c0, w0); load8f(cw + DFF + c0, w1); load8f(cw + 2 * DFF + c0, w2); load8f(cb + c0, bb);
        float u0[8], g0[8], u1[8], u2[8], o[8];
        unpack8(*(const u32x4*)(EF + ((size_t)(blk * 2 + q) * 2) * DFF + c0), u0); unpack8(*(const u32x4*)(EF + ((size_t)(blk * 2 + q) * 2 + 1) * DFF + c0), g0);
#pragma unroll
        for (int e = 0; e < 8; ++e) { u1[e] = 0.f; u2[e] = 0.f; }
        if (t >= 1) { if (q == 1) unpack8(*(const u32x4*)(EF + ((size_t)(blk * 2) * 2) * DFF + c0), u1); else unpack8(*(const u32x4*)(EL + (size_t)((blk - 1) * 2 + 1) * DFF + c0), u1); }
        if (t >= 2) { if (q == 1) unpack8(*(const u32x4*)(EL + (size_t)((blk - 1) * 2 + 1) * DFF + c0), u2); else unpack8(*(const u32x4*)(EL + (size_t)((blk - 1) * 2) * DFF + c0), u2); }
#pragma unroll
        for (int e = 0; e < 8; ++e) { const float uc = w0[e] * u2[e] + w1[e] * u1[e] + w2[e] * u0[e] + bb[e]; o[e] = uc * sigmoidf_(uc) * g0[e]; }
        *(u32x4*)(ACT + (size_t)r * DFF + c0) = pack8(o);
    }
}

#define XB_TMO      128
#define XB_XCNT(j)  (256  + 64 * (j))
#define XB_XSUB(j)  (1280 + 64 * (j))
#define XB_XGEN(j)  (2304 + 64 * (j))
#define XB_TOP      3328
#define XB_TOPGEN   3392
#define XCD_BAR_WORDS 3456
#define XB_SPIN_CAP (1u << 18)
constexpr int LDS_BAR_OFF = 131072, LDS_TOTAL = 131072 + 16;
__device__ __forceinline__ unsigned xb_ld(unsigned* p)              { return __hip_atomic_load(p, __ATOMIC_RELAXED, __HIP_MEMORY_SCOPE_AGENT); }
__device__ __forceinline__ unsigned xb_add(unsigned* p, unsigned v) { return __hip_atomic_fetch_add(p, v, __ATOMIC_RELAXED, __HIP_MEMORY_SCOPE_AGENT); }
__device__ __forceinline__ unsigned xb_xcc_id() { return (unsigned)__builtin_amdgcn_s_getreg((3 << 11) | 20) & 0xFu; }
#define XB_SPIN(cond, bar) do { unsigned _sp = 0; while (cond) { __builtin_amdgcn_s_sleep(1); \
    if ((++_sp & 255u) == 0u) { if (xb_ld(&(bar)[XB_TMO])) break; if (_sp > XB_SPIN_CAP) { atomicAdd(&(bar)[XB_TMO], 1u); break; } } } } while (0)
__device__ __forceinline__ void xcd_barrier_complete(unsigned* bar, unsigned x, unsigned& nloc, unsigned& nx) {
    const unsigned G = gridDim.x;
    unsigned sum, cnt, mine, sp = 0u;
    for (;;) {
        sum = 0u; cnt = 0u; mine = 0u;
#pragma unroll
        for (unsigned j = 0; j < 16; ++j) { const unsigned c = xb_ld(&bar[XB_XCNT(j)]); sum += c; cnt += (c > 0u) ? 1u : 0u; mine = (j == x) ? c : mine; }
        if (sum == G) break;
        __builtin_amdgcn_s_sleep(1);
        if ((++sp & 255u) == 0u) { if (xb_ld(&bar[XB_TMO])) break; if (sp > XB_SPIN_CAP) { atomicAdd(&bar[XB_TMO], 1u); break; } }
    }
    nloc = mine > 0u ? mine : 1u; nx = cnt > 0u ? cnt : 1u;
}
__device__ __forceinline__ void grid_barrier(LAS unsigned char* lds) {
    asm volatile("s_waitcnt vmcnt(0)" ::: "memory");
    __syncthreads();
    if (tid_() == 0) {
        unsigned* bar = (unsigned*)(kargs()->ws + WS_BAR);
        volatile LAS unsigned* st = (volatile LAS unsigned*)(lds + LDS_BAR_OFF);
        const unsigned x = xb_xcc_id();
        __builtin_amdgcn_s_waitcnt(0);
        unsigned nloc = st[0], nx = st[1];
        if (nloc == 0u) { xcd_barrier_complete(bar, x, nloc, nx); st[0] = nloc; st[1] = nx; }
        const unsigned old = xb_add(&bar[XB_XSUB(x)], 1u);
        const unsigned gen = old / nloc;
        if (old + 1u == (gen + 1u) * nloc) {
            __builtin_amdgcn_fence(__ATOMIC_RELEASE, "agent");
            asm volatile("s_waitcnt vmcnt(0)" ::: "memory");
            const unsigned og = xb_add(&bar[XB_TOP], 1u);
            const unsigned tg = og / nx;
            if (og + 1u == (tg + 1u) * nx) xb_add(&bar[XB_TOPGEN], 1u);
            else XB_SPIN(xb_ld(&bar[XB_TOPGEN]) == tg, bar);
            __builtin_amdgcn_fence(__ATOMIC_ACQUIRE, "agent");
            xb_add(&bar[XB_XGEN(x)], 1u);
            asm volatile("s_waitcnt vmcnt(0)" ::: "memory");
        } else {
            XB_SPIN(xb_ld(&bar[XB_XGEN(x)]) == gen, bar);
            __builtin_amdgcn_fence(__ATOMIC_ACQUIRE, "agent");
            asm volatile("s_waitcnt vmcnt(0)" ::: "memory");
        }
    }
    __syncthreads();
}

__global__ void __launch_bounds__(512, 2) fwd_megakernel(Params pv) {
    extern __shared__ __attribute__((aligned(16))) unsigned char shm[];
    LAS unsigned char* lds = (LAS unsigned char*)shm;
    cg::grid_group grid = cg::this_grid();
    if (tid_() < 4) ((LAS unsigned*)(lds + LDS_BAR_OFF))[tid_()] = 0u;
    __syncthreads();
    if (bid_() == 0) { unsigned* bw = (unsigned*)(kargs()->ws + WS_BAR); for (int i = tid_(); i < 4096; i += 512) __hip_atomic_store(bw + i, 0u, __ATOMIC_RELAXED, __HIP_MEMORY_SCOPE_AGENT); }
    grid.sync();
    if (tid_() == 0) (void)xb_add(&((unsigned*)(kargs()->ws + WS_BAR))[XB_XCNT(xb_xcc_id())], 1u);
    for (int l = 0; l < DEPTH; ++l) {
        if (l == 0) convert_phase(kargs(), 0, 0, bid_(), gdim_());
        norm_phase(kargs(), l == 0, 11);
        grid_barrier(lds);
        { KP p = kargs(); unsigned char* ws = p->ws; pg8::Gemm g{(const bf16_t*)(ws + WS_R2), nullptr, (const bf16_t*)(ws + WS_WIN), nullptr, D, D}; pg8::Order S; S.init(M, DIN, D, gdim_(), bid_(), 1, 0);
          pg8::EpiProj E{(bf16_t*)(ws + WS_BIG), (const float*)(ws + WS_BIASP), (bf16_t*)(ws + WS_SLAB), (bf16_t*)(ws + WS_SLAB) + (size_t)260 * 2 * 2 * D, p->in[12] + (size_t)l * 3 * D,
                         p->in[2] + (size_t)l * MS * 2 * D, p->out + O_PCA + (size_t)l * NB * 2 * D, p->out + O_SCA + (size_t)l * MS * 2 * D};
          pg8::gemm_phase(lds, g, S, E); }
        if (bid_() >= 28) convert_phase(kargs(), l, 1, bid_() - 28, gdim_() - 28);
        grid_barrier(lds);
        mixa_edge_phase(kargs(), l);
        scan_phase(kargs(), l, lds);
        grid_barrier(lds);
        fixup_phase(kargs(), l);
        grid_barrier(lds);
        { unsigned char* ws = kargs()->ws; bf16_t* BIG = (bf16_t*)(ws + WS_BIG);
          pg8::Gemm g{BIG + C_UA, BIG + C_GR, (const bf16_t*)(ws + WS_WA), (const bf16_t*)(ws + WS_WB), DP, D}; pg8::Order S; S.init(M, D, D, gdim_(), bid_(), 2, 4);
          pg8::EpiAB E{BIG, (float*)(ws + WS_SLAB), D / 64}; pg8::gemm_phase(lds, g, S, E); }
        grid_barrier(lds);
        mixed_fold_phase(kargs());
        grid_barrier(lds);
        { unsigned char* ws = kargs()->ws; pg8::Gemm g{(const bf16_t*)(ws + WS_BIG) + C_MIX, nullptr, (const bf16_t*)(ws + WS_WO), nullptr, DP, D}; pg8::Order S; S.init(M, D, D, gdim_(), bid_(), 1, 4);
          pg8::EpiRes E{(bf16_t*)(ws + WS_X), (float*)(ws + WS_SLAB), D / 64}; pg8::gemm_phase(lds, g, S, E); }
        grid_barrier(lds);
        norm_phase(kargs(), false, 4);
        grid_barrier(lds);
        { KP p = kargs(); unsigned char* ws = p->ws; pg8::Gemm g{(const bf16_t*)(ws + WS_R2), nullptr, (const bf16_t*)(ws + WS_WUG), nullptr, D, D}; pg8::Order S; S.init(M, DUG, D, gdim_(), bid_(), 1, 0);
          pg8::EpiFfn E{(bf16_t*)(ws + WS_BIG), (bf16_t*)(ws + WS_SLAB), (bf16_t*)(ws + WS_SLAB) + (size_t)260 * 2 * 2 * DFF, p->in[25] + (size_t)l * 3 * DFF, p->in[26] + (size_t)l * DFF,
                        p->in[5] + (size_t)l * MS * 2 * DFF, p->out + O_PCF + (size_t)l * NB * 2 * DFF, p->out + O_SCF + (size_t)l * MS * 2 * DFF};
          pg8::gemm_phase(lds, g, S, E); }
        if (l + 1 < DEPTH && bid_() >= 150) convert_phase(kargs(), l + 1, 0, bid_() - 150, gdim_() - 150);
        grid_barrier(lds);
        ffn_edge_phase(kargs(), l);
        grid_barrier(lds);
        { unsigned char* ws = kargs()->ws; pg8::Gemm g{(const bf16_t*)(ws + WS_BIG), nullptr, (const bf16_t*)(ws + WS_WD), nullptr, DFF, DFF}; pg8::Order S; S.init(M, D, DFF, gdim_(), bid_(), 1, 11);
          pg8::EpiRes E{(bf16_t*)(ws + WS_X), (float*)(ws + WS_SLAB), DFF / 64}; pg8::gemm_phase(lds, g, S, E); }
        grid_barrier(lds);
    }
    final_norm_phase(kargs());
}

extern "C" void kernel_launch(void* const* d_in, const int* in_sizes, int n_in, void* d_out, int out_size, void* d_ws, size_t ws_size, hipStream_t stream) {
    static int grid = 0;
    if (grid == 0) {
        if (n_in != 28 || (size_t)out_size != O_END || ws_size < WS_END) { fprintf(stderr, "kernel_launch: unexpected shapes: n_in %d out %d ws %zu (need %zu)\n", n_in, out_size, ws_size, (size_t)WS_END); grid = -1; return; }
        int dev = 0, cus = 0, per_cu = 0;
        hipGetDevice(&dev); hipDeviceGetAttribute(&cus, hipDeviceAttributeMultiprocessorCount, dev);
        if (hipFuncSetAttribute((const void*)fwd_megakernel, hipFuncAttributeMaxDynamicSharedMemorySize, LDS_TOTAL) != hipSuccess) { fprintf(stderr, "kernel_launch: hipFuncSetAttribute failed\n"); grid = -1; return; }
        hipOccupancyMaxActiveBlocksPerMultiprocessor(&per_cu, (const void*)fwd_megakernel, 512, LDS_TOTAL);
        if (per_cu < 1) { fprintf(stderr, "kernel_launch: occupancy query says %d blocks per CU\n", per_cu); (void)hipGetLastError(); per_cu = 1; }
        grid = cus;
    }
    if (grid < 0) return;
    Params p{};
    for (int i = 0; i < 28; ++i) p.in[i] = (const float*)d_in[i];
    p.out = (float*)d_out; p.ws = (unsigned char*)d_ws;
    void* args[] = {&p};
    hipError_t e = hipLaunchCooperativeKernel((const void*)fwd_megakernel, dim3(grid), dim3(512), args, LDS_TOTAL, stream);
    if (e != hipSuccess) fprintf(stderr, "cooperative launch failed: %s (grid %d)\n", hipGetErrorString(e), grid);
}
```
